# Optimizing an MI355X kernel written in HIP

```python
import math
import jax, jax.numpy as jnp
from jax import lax
import numpy as np

D_MODEL = 2048
BATCH = 8
SEQ = 2048
DEPTH = 2

N_MEM = 256
MAX_POS_OFFSET = 4096
ROPE_THETA = 10000.0
NORM_EPS = 1e-6
BLOCK_Q = 128
NEG_INF = -1e30
FORCE_SCORE = 1e6

A_HEADS = 8
A_KV_HEADS = 2
A_HEAD_DIM = 64
A_WINDOW = 128

B_HEADS = 8
B_KV_GROUPS = 2
B_HEAD_DIM = 128
CMP_LEN = 32
CMP_STRIDE = 16
SLC_LEN = 64
SLC_TOPN = 8
SLC_QBLOCK = 64
B_WINDOW = 512

C_HEADS = 4
C_HEAD_DIM = 64

X_HEADS = 4
X_HEAD_DIM = 128
X_WIDTH = X_HEADS * X_HEAD_DIM

N_GROUPS = 4
EXPERTS_PER_GROUP = 4
N_EXPERTS = N_GROUPS * EXPERTS_PER_GROUP
TOP_K_IN_GROUP = 2
D_FF_EXPERT = 1024

A_Q_W = A_HEADS * A_HEAD_DIM
A_KV_W = A_KV_HEADS * A_HEAD_DIM
B_Q_W = B_HEADS * B_HEAD_DIM
B_KV_W = B_KV_GROUPS * B_HEAD_DIM
B_GATE_W = 3 * B_HEADS
C_QK_W = C_HEADS * 2 * C_HEAD_DIM
C_V_W = C_HEADS * 2 * C_HEAD_DIM
MERGE_W = 3 * D_MODEL
IN_SIZES = (A_Q_W, A_KV_W, A_KV_W,
            B_Q_W, B_KV_W, B_KV_W, B_KV_W, B_KV_W, B_KV_W, B_KV_W, B_GATE_W,
            C_QK_W, C_QK_W, C_V_W,
            MERGE_W)
IN_WIDTH = sum(IN_SIZES)

kernel_name = 'hybrid_swa_nsa_diff_memx_hmoe'


def _split_points():
    pts, acc = [], 0
    for s in IN_SIZES[:-1]:
        acc += s
        pts.append(acc)
    return pts


def rms_norm(x, g):
    xf = x.astype(jnp.float32)
    y = xf * lax.rsqrt(jnp.mean(xf * xf, axis=-1, keepdims=True) + NORM_EPS)
    return (y * g.astype(jnp.float32)).astype(x.dtype)


def split_heads(t, h):
    b, s, _ = t.shape
    return t.reshape(b, s, h, -1).transpose(0, 2, 1, 3)


def merge_heads(o):
    b, h, s, d = o.shape
    return o.transpose(0, 2, 1, 3).reshape(b, s, h * d)


def rope(x, pos):
    d = x.shape[-1]
    inv = jnp.power(ROPE_THETA, -jnp.arange(0, d, 2, dtype=jnp.float32) / d)
    ang = pos.astype(jnp.float32)[:, None, :, None] * inv
    cos, sin = jnp.cos(ang), jnp.sin(ang)
    xf = x.astype(jnp.float32)
    x1, x2 = xf[..., : d // 2], xf[..., d // 2:]
    return jnp.concatenate([x1 * cos - x2 * sin, x2 * cos + x1 * sin], axis=-1).astype(x.dtype)


def banded_gqa_attention(q, k, v, window, sink):
    b, h, s, d = q.shape
    g = k.shape[1]
    r = h // g
    nb = s // BLOCK_Q
    p_prev = -(-window // BLOCK_Q)
    pad = ((0, 0), (0, 0), (p_prev * BLOCK_Q, 0), (0, 0))
    kp = jnp.pad(k, pad).reshape(b, g, nb + p_prev, BLOCK_Q, d)
    vp = jnp.pad(v, pad).reshape(b, g, nb + p_prev, BLOCK_Q, v.shape[-1])
    kb = jnp.concatenate([kp[:, :, i:i + nb] for i in range(p_prev + 1)], axis=3)
    vb = jnp.concatenate([vp[:, :, i:i + nb] for i in range(p_prev + 1)], axis=3)
    qb = q.reshape(b, g, r, nb, BLOCK_Q, d)
    sc = jnp.einsum('bgrnqd,bgnkd->bgrnqk', qb, kb).astype(jnp.float32) * (d ** -0.5)
    qpos = jnp.arange(nb)[:, None] * BLOCK_Q + jnp.arange(BLOCK_Q)[None, :]
    kpos = (jnp.arange(nb)[:, None] - p_prev) * BLOCK_Q + jnp.arange((p_prev + 1) * BLOCK_Q)[None, :]
    rel = qpos[:, :, None] - kpos[:, None, :]
    ok = (rel >= 0) & (rel < window) & (kpos[:, None, :] >= 0)
    sc = jnp.where(ok, sc, NEG_INF)
    if sink is None:
        p = jax.nn.softmax(sc, axis=-1)
    else:
        sk = sink.astype(jnp.float32).reshape(1, g, r, 1, 1, 1)
        m = jnp.maximum(jnp.max(sc, axis=-1, keepdims=True), sk)
        e = jnp.exp(sc - m)
        p = e / (jnp.sum(e, axis=-1, keepdims=True) + jnp.exp(sk - m))
    o = jnp.einsum('bgrnqk,bgnkd->bgrnqd', p.astype(vb.dtype), vb)
    return o.reshape(b, h, s, v.shape[-1])


def swa_sink_mixer(q_in, k_in, v_in, sinks, pos):
    q = rope(split_heads(q_in, A_HEADS), pos)
    k = rope(split_heads(k_in, A_KV_HEADS), pos)
    v = split_heads(v_in, A_KV_HEADS)
    return merge_heads(banded_gqa_attention(q, k, v, A_WINDOW, sinks))


def compress_blocks(t, pos_emb, w1, w2):
    b, g, s, d = t.shape
    nc = (s - CMP_LEN) // CMP_STRIDE + 1
    idx = jnp.arange(nc)[:, None] * CMP_STRIDE + jnp.arange(CMP_LEN)[None, :]
    blocks = t[:, :, idx] + pos_emb
    hid = jax.nn.silu(blocks.reshape(b, g, nc, CMP_LEN * d) @ w1)
    return hid @ w2


def nsa_mixer(q_in, kc_in, vc_in, ks_in, vs_in, kw_in, vw_in, gate_in, pos,
              cmp_pos_k, cmp_pos_v, phi_k1, phi_k2, phi_v1, phi_v2):
    b, s, _ = q_in.shape
    g, r, d = B_KV_GROUPS, B_HEADS // B_KV_GROUPS, B_HEAD_DIM
    scale = d ** -0.5
    t = jnp.arange(s)
    q = rope(split_heads(q_in, B_HEADS), pos)
    qg = q.reshape(b, g, r, s, d)

    kc = compress_blocks(rope(split_heads(kc_in, g), pos), cmp_pos_k, phi_k1, phi_k2)
    vc = compress_blocks(split_heads(vc_in, g), cmp_pos_v, phi_v1, phi_v2)
    nc = kc.shape[2]
    c_start = jnp.arange(nc) * CMP_STRIDE
    cmp_ok = t[:, None] >= (c_start + CMP_LEN - 1)[None, :]
    s_cmp = jnp.einsum('bgrsd,bgcd->bgrsc', qg, kc).astype(jnp.float32) * scale
    p_cmp = jnp.where(cmp_ok, jax.nn.softmax(jnp.where(cmp_ok, s_cmp, NEG_INF), axis=-1), 0.0)
    o_cmp = jnp.einsum('bgrsc,bgcd->bgrsd', p_cmp.astype(vc.dtype), vc).reshape(b, B_HEADS, s, d)

    ns = s // SLC_LEN
    n_sel = min(SLC_TOPN, ns)
    j = jnp.arange(ns)
    overlap = ((c_start[:, None] < (j[None, :] + 1) * SLC_LEN)
               & (c_start[:, None] + CMP_LEN > j[None, :] * SLC_LEN)).astype(jnp.float32)
    imp = jnp.einsum('bgrsc,cj->bgsj', p_cmp, overlap)
    cur = (t // SLC_LEN)[:, None]
    forced = (j[None, :] == 0) | (j[None, :] == cur) | (j[None, :] == cur - 1)
    future = j[None, :] * SLC_LEN > t[:, None]
    imp = jnp.where(future, -1.0, jnp.where(forced, FORCE_SCORE, imp))
    _, sel = lax.top_k(imp, n_sel)

    ks = rope(split_heads(ks_in, g), pos).reshape(b, g, ns, SLC_LEN, d)
    vs = split_heads(vs_in, g).reshape(b, g, ns, SLC_LEN, d)
    nqb = s // SLC_QBLOCK
    q_blocks = jnp.moveaxis(qg.reshape(b, g, r, nqb, SLC_QBLOCK, d), 3, 0)
    sel_blocks = jnp.moveaxis(sel.reshape(b, g, nqb, SLC_QBLOCK, n_sel), 2, 0)
    t_blocks = t.reshape(nqb, SLC_QBLOCK)
    bi = jnp.arange(b)[:, None, None, None]
    gi = jnp.arange(g)[None, :, None, None]

    def attend_selected(args):
        qb, sb, tq = args
        kg = ks[bi, gi, sb]
        vg = vs[bi, gi, sb]
        kpos = sb[..., None] * SLC_LEN + jnp.arange(SLC_LEN)
        ok = kpos <= tq[None, None, :, None, None]
        sc = jnp.einsum('bgrqd,bgqnld->bgrqnl', qb, kg).astype(jnp.float32) * scale
        sc = jnp.where(ok[:, :, None], sc, NEG_INF)
        p = jax.nn.softmax(sc.reshape(b, g, r, SLC_QBLOCK, n_sel * SLC_LEN), axis=-1).reshape(sc.shape)
        return jnp.einsum('bgrqnl,bgqnld->bgrqd', p.astype(vg.dtype), vg)

    o_slc = lax.map(attend_selected, (q_blocks, sel_blocks, t_blocks))
    o_slc = jnp.moveaxis(o_slc, 0, 3).reshape(b, B_HEADS, s, d)

    kw = rope(split_heads(kw_in, g), pos)
    vw = split_heads(vw_in, g)
    o_win = banded_gqa_attention(q, kw, vw, B_WINDOW, None)

    gts = jax.nn.sigmoid(gate_in.astype(jnp.float32)).reshape(b, s, B_HEADS, 3).transpose(0, 2, 1, 3)
    gts = gts.astype(q.dtype)
    o = gts[..., 0:1] * o_cmp + gts[..., 1:2] * o_slc + gts[..., 2:3] * o_win
    return merge_heads(o)


def diff_mixer(q_in, k_in, v_in, pos, lq1, lk1, lq2, lk2, g_sub, lambda_init):
    b, s, _ = q_in.shape
    h, d = C_HEADS, C_HEAD_DIM
    scale = d ** -0.5
    q = rope(split_heads(q_in, 2 * h), pos).reshape(b, h, 2, s, d)
    k = rope(split_heads(k_in, 2 * h), pos).reshape(b, h, 2, s, d)
    v = split_heads(v_in, h)
    lam = (jnp.exp(jnp.sum(lq1.astype(jnp.float32) * lk1.astype(jnp.float32)))
           - jnp.exp(jnp.sum(lq2.astype(jnp.float32) * lk2.astype(jnp.float32))) + lambda_init)
    nb = s // BLOCK_Q
    q_blocks = jnp.moveaxis(q.reshape(b, h, 2, nb, BLOCK_Q, d), 3, 0)
    t_blocks = jnp.arange(s).reshape(nb, BLOCK_Q)
    kpos = jnp.arange(s)

    def attend(args):
        qb, tq = args
        sc = jnp.einsum('bhcqd,bhckd->bhcqk', qb, k).astype(jnp.float32) * scale
        sc = jnp.where(kpos[None, :] <= tq[:, None], sc, NEG_INF)
        a = jax.nn.softmax(sc, axis=-1)
        w = a[:, :, 0] - lam * a[:, :, 1]
        return jnp.einsum('bhqk,bhkd->bhqd', w.astype(v.dtype), v)

    o = lax.map(attend, (q_blocks, t_blocks))
    o = jnp.moveaxis(o, 0, 2).reshape(b, h, s, 2 * d)
    o = rms_norm(o, g_sub) * (1.0 - lambda_init)
    return merge_heads(o)


def memory_cross_attention(hx, hm, w_xq, w_xkv, w_xo):
    q = split_heads(hx @ w_xq, X_HEADS)
    kv = hm @ w_xkv
    k = split_heads(kv[..., :X_WIDTH], X_HEADS)
    v = split_heads(kv[..., X_WIDTH:], X_HEADS)
    sc = jnp.einsum('bhsd,bhmd->bhsm', q, k).astype(jnp.float32) * (X_HEAD_DIM ** -0.5)
    p = jax.nn.softmax(sc, axis=-1)
    o = jnp.einsum('bhsm,bhmd->bhsd', p.astype(v.dtype), v)
    return merge_heads(o) @ w_xo


def hier_moe(hn, w_group, b_group, w_expert, b_expert, w_gate, w_up, w_down):
    b, s, dm = hn.shape
    t = hn.reshape(b * s, dm)
    pg = jax.nn.softmax((t @ w_group + b_group).astype(jnp.float32), axis=-1)
    gp, gi = lax.top_k(pg, 1)
    le = (t @ w_expert + b_expert).astype(jnp.float32).reshape(-1, N_GROUPS, EXPERTS_PER_GROUP)
    le = jnp.take_along_axis(le, gi[:, :, None], axis=1)[:, 0]
    pe = jax.nn.softmax(le, axis=-1)
    ew, ei = lax.top_k(pe, TOP_K_IN_GROUP)
    w = gp * ew / jnp.sum(ew, axis=-1, keepdims=True)
    eid = gi * EXPERTS_PER_GROUP + ei
    combine = jnp.sum(jax.nn.one_hot(eid, N_EXPERTS, dtype=jnp.float32) * w[..., None], axis=1).astype(t.dtype)
    out = jnp.zeros_like(t)
    for e in range(N_EXPERTS):
        he = jax.nn.silu(t @ w_gate[e]) * (t @ w_up[e])
        out = out + combine[:, e:e + 1] * (he @ w_down[e])
    return out.reshape(b, s, dm)


def setup_inputs(seed: int = 0) -> dict:
    key = jax.random.key(seed)
    keys = iter(jax.random.split(key, 40))

    def nrm(shape, scale):
        return jax.random.normal(next(keys), shape, jnp.float32) * scale

    def gain(shape):
        return 1.0 + nrm(shape, 0.02)

    L = DEPTH
    x = nrm((BATCH, SEQ, D_MODEL), 1.0)
    mem = nrm((BATCH, N_MEM, D_MODEL), 1.0)
    positions = (jnp.arange(SEQ, dtype=jnp.int32)[None, :]
                 + jax.random.randint(next(keys), (BATCH, 1), 0, MAX_POS_OFFSET, dtype=jnp.int32))
    return {
        'x': x,
        'mem': mem,
        'positions': positions,
        'g_mix': gain((L, D_MODEL)),
        'w_in': nrm((L, D_MODEL, IN_WIDTH), D_MODEL ** -0.5),
        'sinks_a': nrm((L, A_HEADS), 0.5),
        'cmp_pos_k': nrm((L, CMP_LEN, B_HEAD_DIM), 0.1),
        'cmp_pos_v': nrm((L, CMP_LEN, B_HEAD_DIM), 0.1),
        'phi_k1': nrm((L, CMP_LEN * B_HEAD_DIM, B_HEAD_DIM), (CMP_LEN * B_HEAD_DIM) ** -0.5),
        'phi_k2': nrm((L, B_HEAD_DIM, B_HEAD_DIM), B_HEAD_DIM ** -0.5),
        'phi_v1': nrm((L, CMP_LEN * B_HEAD_DIM, B_HEAD_DIM), (CMP_LEN * B_HEAD_DIM) ** -0.5),
        'phi_v2': nrm((L, B_HEAD_DIM, B_HEAD_DIM), B_HEAD_DIM ** -0.5),
        'lq1': nrm((L, C_HEAD_DIM), 0.1),
        'lk1': nrm((L, C_HEAD_DIM), 0.1),
        'lq2': nrm((L, C_HEAD_DIM), 0.1),
        'lk2': nrm((L, C_HEAD_DIM), 0.1),
        'g_diff': gain((L, 2 * C_HEAD_DIM)),
        'w_pa': nrm((L, A_Q_W, D_MODEL), A_Q_W ** -0.5),
        'w_pb': nrm((L, B_Q_W, D_MODEL), B_Q_W ** -0.5),
        'w_pc': nrm((L, C_V_W, D_MODEL), C_V_W ** -0.5),
        'w_out': nrm((L, D_MODEL, D_MODEL), D_MODEL ** -0.5),
        'g_x': gain((L, D_MODEL)),
        'g_mem': gain((L, D_MODEL)),
        'w_xq': nrm((L, D_MODEL, X_WIDTH), D_MODEL ** -0.5),
        'w_xkv': nrm((L, D_MODEL, 2 * X_WIDTH), D_MODEL ** -0.5),
        'w_xo': nrm((L, X_WIDTH, D_MODEL), X_WIDTH ** -0.5),
        'g_ffn': gain((L, D_MODEL)),
        'w_group': nrm((L, D_MODEL, N_GROUPS), D_MODEL ** -0.5),
        'b_group': nrm((L, N_GROUPS), 0.01),
        'w_expert': nrm((L, D_MODEL, N_EXPERTS), D_MODEL ** -0.5),
        'b_expert': nrm((L, N_EXPERTS), 0.01),
        'w_gate': nrm((L, N_EXPERTS, D_MODEL, D_FF_EXPERT), D_MODEL ** -0.5),
        'w_up': nrm((L, N_EXPERTS, D_MODEL, D_FF_EXPERT), D_MODEL ** -0.5),
        'w_down': nrm((L, N_EXPERTS, D_FF_EXPERT, D_MODEL), D_FF_EXPERT ** -0.5),
        'g_final': gain((D_MODEL,)),
    }


def reference(x, mem, positions, g_mix, w_in, sinks_a, cmp_pos_k, cmp_pos_v,
              phi_k1, phi_k2, phi_v1, phi_v2, lq1, lk1, lq2, lk2, g_diff,
              w_pa, w_pb, w_pc, w_out, g_x, g_mem, w_xq, w_xkv, w_xo,
              g_ffn, w_group, b_group, w_expert, b_expert, w_gate, w_up, w_down, g_final):
    split_pts = _split_points()
    for l in range(DEPTH):
        lambda_init = 0.8 - 0.6 * math.exp(-0.3 * l)
        h = rms_norm(x, g_mix[l])
        proj = h @ w_in[l]
        (qa, ka, va, qb, kcb, vcb, ksb, vsb, kwb, vwb, gate_b,
         qc, kc, vc, merge_logits) = jnp.split(proj, split_pts, axis=-1)
        o_a = swa_sink_mixer(qa, ka, va, sinks_a[l], positions)
        o_b = nsa_mixer(qb, kcb, vcb, ksb, vsb, kwb, vwb, gate_b, positions,
                        cmp_pos_k[l], cmp_pos_v[l], phi_k1[l], phi_k2[l], phi_v1[l], phi_v2[l])
        o_c = diff_mixer(qc, kc, vc, positions, lq1[l], lk1[l], lq2[l], lk2[l], g_diff[l], lambda_init)
        gates = jax.nn.sigmoid(merge_logits.astype(jnp.float32)).astype(x.dtype)
        gate_a, gate_bb, gate_c = jnp.split(gates, 3, axis=-1)
        merged = (gate_a * (o_a @ w_pa[l]) + gate_bb * (o_b @ w_pb[l]) + gate_c * (o_c @ w_pc[l]))
        x = x + merged @ w_out[l]
        x = x + memory_cross_attention(rms_norm(x, g_x[l]), rms_norm(mem, g_mem[l]),
                                       w_xq[l], w_xkv[l], w_xo[l])
        x = x + hier_moe(rms_norm(x, g_ffn[l]), w_group[l], b_group[l], w_expert[l], b_expert[l],
                         w_gate[l], w_up[l], w_down[l])
    return rms_norm(x, g_final)
```

```cpp
#include <hip/hip_runtime.h>
#include <cstdint>
#include <cstdio>

#define LAS __attribute__((address_space(3)))
#define GAS __attribute__((address_space(1)))
typedef unsigned short bf16_t;
typedef short bf16x8 __attribute__((ext_vector_type(8)));
typedef short v4i16_t __attribute__((ext_vector_type(4)));
typedef float f32x2 __attribute__((ext_vector_type(2)));
typedef float f32x4 __attribute__((ext_vector_type(4)));
typedef float f32x16 __attribute__((ext_vector_type(16)));
typedef unsigned u32x2 __attribute__((ext_vector_type(2)));
typedef unsigned u32x4 __attribute__((ext_vector_type(4)));
typedef __bf16 bf16x2_t __attribute__((ext_vector_type(2)));

constexpr int DM = 2048, NB = 8, SEQ = 2048, NTOK = NB * SEQ, NMEM = 256, DEPTH = 2;
constexpr int INW = 11032, INV = 11264;
constexpr int NEXP = 16, DFF = 1024;
constexpr float EPS = 1e-6f;
constexpr float LOG2E = 1.4426950408889634f;
constexpr float QSC64 = 0.125f * LOG2E, QSC128 = 0.08838834764831845f * LOG2E;

constexpr size_t MiB = 1u << 20;
constexpr size_t WS_CTL = 0, CTL_BYTES = 1 * MiB;
constexpr size_t WS_WIN = 1 * MiB;
#ifndef INPROJ_BF16_TILES
#define INPROJ_BF16_TILES 8
#endif
#if INPROJ_BF16_TILES == 8
constexpr int NV16 = 2048, NV8 = 9216;
__host__ __device__ constexpr int tile_of_bf16(int pn) { return pn < 2 ? pn : pn + 11; }
__host__ __device__ constexpr int tile_of_fp8(int pn) { return pn < 11 ? pn + 2 : (pn == 11 ? 19 : pn + 8); }
__host__ __device__ constexpr int local_of_tile(int t, bool& f8) { if (t < 2) { f8 = false; return t; } if (t >= 13 && t < 19) { f8 = false; return t - 11; } f8 = true; return t < 13 ? t - 2 : (t == 19 ? 11 : t - 8); }
#else
constexpr int NV16 = 1024, NV8 = 10240;
__host__ __device__ constexpr int tile_of_bf16(int pn) { return pn + 13; }
__host__ __device__ constexpr int tile_of_fp8(int pn) { return pn < 13 ? pn : pn + 4; }
__host__ __device__ constexpr int local_of_tile(int t, bool& f8) { if (t >= 13 && t < 17) { f8 = false; return t - 13; } f8 = true; return t < 13 ? t : t - 4; }
#endif
constexpr size_t WS_WIN8 = WS_WIN + 16 * MiB;
constexpr size_t WS_WPCAT = WS_WIN + 88 * MiB;
constexpr size_t WS_WOUT = WS_WPCAT + 16 * MiB;
constexpr size_t WS_WXCAT = WS_WOUT + 16 * MiB;
constexpr size_t WS_WXO = WS_WXCAT + 12 * MiB;
constexpr size_t WS_PHI1 = WS_WXO + 4 * MiB;
constexpr size_t WS_PHI2 = WS_PHI1 + 4 * MiB;
constexpr size_t WS_WGU = WS_PHI2 + 1 * MiB;
constexpr size_t WS_WD = WS_WGU + 128 * MiB;
constexpr size_t WS_ROPE128 = WS_WD + 64 * MiB;
constexpr size_t WS_ROPE64 = WS_ROPE128 + 8 * MiB;
constexpr size_t WS_WRT = WS_ROPE64 + 4 * MiB;
constexpr size_t WS_CBIAS = WS_WRT + 1 * MiB;
constexpr size_t WS_TOK = WS_CBIAS + 1 * MiB;
constexpr size_t WS_WT = WS_TOK + 1 * MiB;
constexpr size_t WS_X = WS_WT + 1 * MiB;
constexpr size_t WS_RSTDT = WS_X + 64 * MiB;
constexpr size_t WS_HA = WS_X + 128 * MiB;
constexpr size_t WS_HM = WS_HA + 64 * MiB;
constexpr size_t WS_QKV = WS_HM + 8 * MiB;
constexpr size_t WS_QA = WS_QKV, WS_KA = WS_QA + 16 * MiB, WS_VA = WS_KA + 4 * MiB, WS_QB = WS_VA + 4 * MiB;
constexpr size_t WS_KCB = WS_QB + 32 * MiB, WS_VCB = WS_KCB + 9 * MiB, WS_KSB = WS_VCB + 9 * MiB, WS_VSB = WS_KSB + 8 * MiB, WS_KWB = WS_VSB + 8 * MiB, WS_VWB = WS_KWB + 8 * MiB;
constexpr size_t WS_QC = WS_VWB + 8 * MiB, WS_KC = WS_QC + 16 * MiB, WS_VC = WS_KC + 16 * MiB, WS_GATEB = WS_VC + 16 * MiB, WS_KCMP = WS_GATEB + 2 * MiB, WS_VCMP = WS_KCMP + 1 * MiB;
constexpr size_t WS_QKV_END = WS_VCMP + 1 * MiB;
constexpr size_t WS_QX = WS_QKV, WS_KVM = WS_QX + 16 * MiB, WS_OX = WS_KVM + 4 * MiB;
constexpr size_t WS_MG = WS_QKV_END;
constexpr size_t WS_HMOE = WS_MG;
constexpr size_t WS_Y = WS_QKV;
static_assert(WS_Y + (size_t)36864 * 2048 * 2 <= WS_MG, "Y overlay");
constexpr size_t WS_OCAT = WS_MG + 192 * MiB;
constexpr size_t WS_SSQ = WS_OCAT + 64 * MiB;
constexpr size_t WS_RSTD = WS_SSQ + 4 * MiB;
constexpr size_t WS_END = WS_RSTD + 1 * MiB;
static_assert(WS_END <= 1000 * MiB, "workspace map");

constexpr int CW_BAR = 4096;
constexpr int CW_CNT = 16384;
constexpr int CW_Q = 32768;
constexpr int CW_CH = 57344;
constexpr int CW_CD = 49152;

constexpr int RING_BYTES = 131072, MISC_OFF = RING_BYTES + 320, LDS_BYTES = 147456;

#define LOG2E_ 1.4426950408889634f
__device__ __forceinline__ unsigned f2bf(float f) { unsigned u = __builtin_bit_cast(unsigned, f); return (u + 0x7fffu + ((u >> 16) & 1u)) >> 16; }
__device__ __forceinline__ unsigned pk2(float lo, float hi) { f32x2 v = {lo, hi}; bf16x2_t b = __builtin_convertvector(v, bf16x2_t); return __builtin_bit_cast(unsigned, b); }
typedef int v8i32 __attribute__((ext_vector_type(8)));
constexpr float SA8 = 32.f, SW8 = 512.f;
__device__ __forceinline__ unsigned pk4_fp8(float a, float b, float c, float d) {
    a = fminf(fmaxf(a, -448.f), 448.f); b = fminf(fmaxf(b, -448.f), 448.f); c = fminf(fmaxf(c, -448.f), 448.f); d = fminf(fmaxf(d, -448.f), 448.f);
    unsigned w = 0u; w = __builtin_amdgcn_cvt_pk_fp8_f32(a, b, w, false); w = __builtin_amdgcn_cvt_pk_fp8_f32(c, d, w, true); return w; }
__device__ __forceinline__ float bf2f(unsigned short h) { return __builtin_bit_cast(float, (unsigned)h << 16); }
__device__ __forceinline__ float sigmoidf_(float z) { return __builtin_amdgcn_rcpf(1.0f + __builtin_amdgcn_exp2f(-LOG2E_ * z)); }
__device__ __forceinline__ int hw_lane() { return (int)__builtin_amdgcn_mbcnt_hi(~0u, __builtin_amdgcn_mbcnt_lo(~0u, 0u)); }
__device__ __forceinline__ float wave_sum(float v) {
#pragma unroll
    for (int o = 1; o < 64; o <<= 1) v += __shfl_xor(v, o);
    return v;
}

namespace pg8 {
constexpr int BM = 256, BK = 64, HALF = 128, HTB = HALF * BK * 2, STAGE_BYTES = 8 * HTB;
__host__ __device__ __forceinline__ int lds_byte(int r, int c) { const int st = (r >> 4) * 2 + (c >> 5), rr = r & 15, cc = c & 31, ob = rr * 64 + cc * 2; return st * 1024 + (ob ^ (((ob >> 9) & 1) << 5)); }
__host__ __device__ __forceinline__ void stage_rc(int b, int& R, int& C) { const int st = b / 1024, sb = b % 1024, swz = sb ^ (((sb >> 9) & 1) << 5); R = (st >> 1) * 16 + swz / 64; C = (st & 1) * 32 + (swz % 64) / 2; }
__host__ __device__ __forceinline__ int perm32(int rho) { const int n = rho >> 4, i = rho & 15; return 8 * (i >> 2) + 4 * n + (i & 3); }

struct Unit { int pm, pn, e, r; };
struct Gemm { const bf16_t* A; const bf16_t* Bt; int K; int wid; };

template <class Epi, class Sched, bool ALIGN_EPI, bool F8 = false>
__device__ __forceinline__ void gemm_phase(LAS unsigned char* lds, const Gemm g, const Sched& S, const Epi& E) {
    int tid = g.wid * 64 + hw_lane(); asm volatile("" : "+v"(tid));
    const int wid = __builtin_amdgcn_readfirstlane(tid >> 6), lane = tid & 63, wr = wid >> 2, wc = wid & 3, fr = lane & 15, fq = lane >> 4;
    const int KB = F8 ? g.K : g.K * 2, nt = KB / (BK * 2);
    unsigned voffB[2];
#pragma unroll
    for (int i = 0; i < 2; ++i) { int R, C; stage_rc(tid * 16 + i * 8192, R, C); const int Rb = Epi::PERM ? ((R & ~31) + perm32(R & 31)) : R; voffB[i] = (unsigned)(Rb * KB + C * 2); }
    const size_t kstep = (size_t)(BK * 2);
    const size_t hstep = (size_t)HALF * KB;
    const size_t tstep = 2 * hstep;
    const unsigned ldsw = (unsigned)wid * 1024u;
    const int fcol = fq * 8;
    const int aoff = lds_byte(wr * 64 + fr, fcol), boff = lds_byte(wc * 32 + fr, fcol);
    constexpr int KOFF = 1024;
#define PG8_SA(b, h) (((b) * 2 + (h)) * HTB)
#define PG8_SB(b, h) ((4 + (b) * 2 + (h)) * HTB)
#define PG8_STAGE(bufoff, gbase, voff) do { _Pragma("unroll") for (int _i = 0; _i < 2; ++_i) \
        __builtin_amdgcn_global_load_lds((const unsigned*)((const char*)(gbase) + (voff)[_i]), (LAS unsigned*)(lds + (bufoff) + ldsw + _i * 8192), 16, 0, 0); } while (0)
#define PG8_LDA(dst, b, h) do { _Pragma("unroll") for (int m = 0; m < 4; ++m) _Pragma("unroll") for (int k = 0; k < 2; ++k) dst[m][k] = *(const LAS bf16x8*)(lds + PG8_SA(b, h) + aoff + m * 2048 + k * KOFF); } while (0)
#define PG8_LDB(dst, b, h) do { _Pragma("unroll") for (int n = 0; n < 2; ++n) _Pragma("unroll") for (int k = 0; k < 2; ++k) dst[n][k] = *(const LAS bf16x8*)(lds + PG8_SB(b, h) + boff + n * 2048 + k * KOFF); } while (0)
#define PG8_CAT8(x) __builtin_shufflevector(__builtin_bit_cast(u32x4, x[0]), __builtin_bit_cast(u32x4, x[1]), 0, 1, 2, 3, 4, 5, 6, 7)
#define PG8_MMA(ai, bj, At, Bt) do { __builtin_amdgcn_s_setprio(1); _Pragma("unroll") for (int m = 0; m < 4; ++m) _Pragma("unroll") for (int n = 0; n < 2; ++n) { \
        if constexpr (F8) acc[ai][bj][m][n] = __builtin_amdgcn_mfma_scale_f32_16x16x128_f8f6f4(__builtin_bit_cast(v8i32, PG8_CAT8(Bt[n])), __builtin_bit_cast(v8i32, PG8_CAT8(At[m])), acc[ai][bj][m][n], 0, 0, 0, 0x7f7f7f7f, 0, 0x7f7f7f7f); \
        else { _Pragma("unroll") for (int k = 0; k < 2; ++k) acc[ai][bj][m][n] = __builtin_amdgcn_mfma_f32_16x16x32_bf16(Bt[n][k], At[m][k], acc[ai][bj][m][n], 0, 0, 0); } } \
        __builtin_amdgcn_s_setprio(0); } while (0)
#define PG8_WAIT_V(n) asm volatile("s_waitcnt vmcnt(" #n ")" ::: "memory")
#define PG8_WAIT_L(n) asm volatile("s_waitcnt lgkmcnt(" #n ")" ::: "memory")
#define PG8_BAR __builtin_amdgcn_s_barrier()
#define PG8_SCHED __builtin_amdgcn_sched_barrier(0)
#define PG8_ROWOFFS(dst, u) do { _Pragma("unroll") for (int _i = 0; _i < 2; ++_i) { int _R, _C; stage_rc(tid * 16 + _i * 8192, _R, _C); \
        _Pragma("unroll") for (int _h = 0; _h < 2; ++_h) dst[_h][_i] = S.rowoff(u, _h * HALF + _R) + (unsigned)_C * 2u; } } while (0)
    Unit cur, nxt; int ui = 0;
    if (!S.next(0, cur)) return;
    f32x4 acc[2][2][4][2];
#pragma unroll
    for (int a = 0; a < 2; ++a)
#pragma unroll
        for (int b = 0; b < 2; ++b)
#pragma unroll
            for (int m = 0; m < 4; ++m)
#pragma unroll
                for (int n = 0; n < 2; ++n) acc[a][b][m][n] = (f32x4){0.f, 0.f, 0.f, 0.f};
    bf16x8 At[4][2], B0[2][2], B1[2][2];
    unsigned vA[2][2];
    PG8_ROWOFFS(vA, cur);
    const char* gA = (const char*)g.A;
    const char* cB = (const char*)g.Bt + (size_t)cur.pn * tstep;
    PG8_STAGE(PG8_SB(0, 0), cB, voffB); PG8_STAGE(PG8_SB(0, 1), cB + hstep, voffB); PG8_STAGE(PG8_SA(0, 0), gA, vA[0]); PG8_STAGE(PG8_SA(0, 1), gA, vA[1]);
    if (wr == 1) PG8_BAR;
    PG8_WAIT_V(2); PG8_BAR;
    PG8_STAGE(PG8_SB(1, 0), cB + kstep, voffB); PG8_STAGE(PG8_SA(1, 0), gA + kstep, vA[0]); PG8_STAGE(PG8_SB(1, 1), cB + hstep + kstep, voffB);
    PG8_WAIT_V(6); PG8_BAR;
    for (;;) {
        const bool has_next = S.next(ui + 1, nxt);
        const char* nB = has_next ? (const char*)g.Bt + (size_t)nxt.pn * tstep : cB;
        for (int t = 0; t < nt; t += 2) {
            if constexpr (Epi::HAS_MID) { if (t == E.t1 || t == E.t2) E.mid(acc, cur, t, wr, wc, fr, fq); }
            const bool last = (t == nt - 2);
            const char* a1 = gA + (size_t)(t + 1) * kstep;
            const char* a2 = last ? gA : gA + (size_t)(t + 2) * kstep; const char* b2 = last ? nB : cB + (size_t)(t + 2) * kstep;
            const char* a3 = a2 + kstep; const char* b3 = b2 + kstep;
            PG8_LDB(B0, 0, 0); PG8_LDB(B1, 0, 1); PG8_SCHED; PG8_LDA(At, 0, 0); PG8_STAGE(PG8_SA(1, 1), a1, vA[1]);
            if (last && has_next) { PG8_ROWOFFS(vA, nxt); }
            PG8_WAIT_V(8); PG8_WAIT_L(0); PG8_BAR; PG8_MMA(0, 0, At, B0); PG8_MMA(0, 1, At, B1); PG8_BAR; PG8_SCHED;
            PG8_LDA(At, 0, 1); PG8_STAGE(PG8_SB(0, 0), b2, voffB); PG8_STAGE(PG8_SB(0, 1), b2 + hstep, voffB); PG8_STAGE(PG8_SA(0, 0), a2, vA[0]);
            PG8_WAIT_V(8); PG8_WAIT_L(0); PG8_BAR; PG8_MMA(1, 0, At, B0); PG8_MMA(1, 1, At, B1); PG8_BAR; PG8_SCHED;
            PG8_LDB(B0, 1, 0); PG8_LDB(B1, 1, 1); PG8_SCHED; PG8_LDA(At, 1, 0); PG8_STAGE(PG8_SA(0, 1), a2, vA[1]);
            PG8_WAIT_V(8); PG8_WAIT_L(0); PG8_BAR; PG8_MMA(0, 0, At, B0); PG8_MMA(0, 1, At, B1); PG8_BAR; PG8_SCHED;
            PG8_LDA(At, 1, 1); PG8_STAGE(PG8_SB(1, 0), b3, voffB); PG8_STAGE(PG8_SB(1, 1), b3 + hstep, voffB); PG8_STAGE(PG8_SA(1, 0), a3, vA[0]);
            PG8_WAIT_V(8); PG8_WAIT_L(0); PG8_BAR; PG8_MMA(1, 0, At, B0); PG8_MMA(1, 1, At, B1); PG8_BAR; PG8_SCHED;
        }
        if constexpr (ALIGN_EPI) { if (wr == 0) PG8_BAR; }
        E(acc, cur, wr, wc, fr, fq);
#ifdef EPI_TWICE
        if constexpr (Epi::IDEMP) { asm volatile("" ::: "memory"); __builtin_amdgcn_sched_barrier(0); E(acc, cur, wr, wc, fr, fq); }
#endif
        if (!has_next) break;
#pragma unroll
        for (int a = 0; a < 2; ++a)
#pragma unroll
            for (int b = 0; b < 2; ++b)
#pragma unroll
                for (int m = 0; m < 4; ++m)
#pragma unroll
                    for (int n = 0; n < 2; ++n) acc[a][b][m][n] = (f32x4){0.f, 0.f, 0.f, 0.f};
        cur = nxt; cB = nB; ++ui;
        if constexpr (ALIGN_EPI) { if (wr == 1) PG8_BAR; }
    }
    PG8_WAIT_V(0);
    if constexpr (!ALIGN_EPI) { if (wr == 0) PG8_BAR; }
    PG8_BAR;
#undef PG8_SA
#undef PG8_SB
#undef PG8_STAGE
#undef PG8_LDA
#undef PG8_LDB
#undef PG8_MMA
#undef PG8_CAT8
#undef PG8_WAIT_V
#undef PG8_WAIT_L
#undef PG8_BAR
#undef PG8_SCHED
#undef PG8_ROWOFFS
}

struct StaticOrder {
    int nM, nN, nwg, G, c; unsigned ldab;
    __device__ void init(int M, int N, int G_, int c_, int lda_elems) { nM = M / BM; nN = N / BM; nwg = nM * nN; G = G_; c = c_; ldab = (unsigned)lda_elems * 2u; }
    __device__ __forceinline__ bool next(int i, Unit& u) const {
        const long L = (long)i * G + c; if (L >= nwg) return false;
        int wgid = (int)L; { const int q = nwg / 8, r = nwg % 8, xcd = wgid % 8, off = wgid / 8; wgid = (xcd < r ? xcd * (q + 1) : r * (q + 1) + (xcd - r) * q) + off; }
        const int nig = 8 * nN, gid = wgid / nig, fm = gid * 8, gsz = (nM - fm) < 8 ? (nM - fm) : 8;
        u.pm = fm + ((wgid % nig) % gsz); u.pn = (wgid % nig) / gsz; u.e = 0; u.r = 0; return true;
    }
    __device__ __forceinline__ unsigned rowoff(const Unit& u, int row) const { return (unsigned)(u.pm * BM + row) * ldab; }
};
struct XqOrder {
    int c;
    __device__ __forceinline__ bool next(int i, Unit& u) const {
        if (i > 0 || c >= 160) return false;
        if (c < 128) { u.pm = c >> 1; u.pn = c & 1; } else { const int j = c - 128; u.pm = 64 + (j >> 2); u.pn = 2 + (j & 3); }
        u.e = 0; u.r = 0; return true;
    }
    __device__ __forceinline__ unsigned rowoff(const Unit& u, int row) const { return (u.pm < 64 ? 0u : (unsigned)(WS_HM - WS_X) - 64u * BM * (unsigned)(DM * 2)) + (unsigned)(u.pm * BM + row) * (unsigned)(DM * 2); }
};
struct MoeOrder {
    const volatile LAS int* tab;
    int U, G, c; const int* tok; bool gather; unsigned ldab;
    __device__ void init(const volatile LAS int* tab_, int G_, int c_, const int* tok_, bool gather_, int lda_elems) {
        tab = tab_; U = __builtin_amdgcn_readfirstlane(tab_[NEXP]) * 8; G = G_; c = c_; tok = tok_; gather = gather_; ldab = (unsigned)lda_elems * 2u;
    }
    __device__ __forceinline__ bool next(int i, Unit& u) const {
        const int per = (U + 7) >> 3;
        const int xcd = c & 7, idx = (c >> 3) + i * (G >> 3);
        if (idx >= per) return false;
        const int id = xcd * per + idx; if (id >= U) return false;
        const int rt = id >> 3, pnl = id & 7; int e = 0;
        const volatile LAS int* tab = this->tab; asm volatile("" : "+v"(tab));
#pragma unroll
        for (int k = 1; k < NEXP; ++k) e += (rt >= __builtin_amdgcn_readfirstlane(tab[k])) ? 1 : 0;
        e = __builtin_amdgcn_readfirstlane(e);
        u.pm = rt; u.pn = e * 8 + pnl; u.e = e; u.r = rt - __builtin_amdgcn_readfirstlane(tab[e]); return true;
    }
    __device__ __forceinline__ unsigned rowoff(const Unit& u, int row) const {
        if (!gather) return (unsigned)(u.pm * BM + row) * ldab;
        const int slot = u.r * BM + row; int t = 0; if (slot < __builtin_amdgcn_readfirstlane(tab[NEXP + 1 + u.e])) t = tok[u.e * NTOK + slot];
        return (unsigned)t * ldab;
    }
};
__device__ __forceinline__ void moe_table(volatile LAS int* tab, const unsigned* cntw, int lane) {
    int n = 0; if (lane < NEXP) { n = (int)cntw[lane * 64]; n = n < 0 ? 0 : (n > NTOK ? NTOK : n); }
    const int t = (n + 255) >> 8; int incl = t;
#pragma unroll
    for (int d = 1; d < NEXP; d <<= 1) { const int v = __shfl_up(incl, d); if (lane >= d) incl += v; }
    if (lane < NEXP) { tab[NEXP + 1 + lane] = n; tab[lane] = incl - t; }
    if (lane == NEXP - 1) tab[NEXP] = incl;
}
}

struct TileInfo { unsigned long long off; int ld, cb; float sc; int flags; };
__constant__ TileInfo TILE_INFO[20] = {
    {WS_QA, 512, 0, QSC64, 2}, {WS_QA, 512, 256, QSC64, 2}, {WS_KA, 128, 0, 1.f, 2},
    {WS_QB, 1024, 0, QSC128, 3}, {WS_QB, 1024, 256, QSC128, 3}, {WS_QB, 1024, 512, QSC128, 3}, {WS_QB, 1024, 768, QSC128, 3},
    {WS_KCB, 128, 0, 1.f, 7}, {WS_VCB, 128, 0, 1.f, 5}, {WS_KSB, 256, 0, 1.f, 3}, {WS_VSB, 256, 0, 1.f, 1}, {WS_KWB, 256, 0, 1.f, 3}, {WS_VWB, 256, 0, 1.f, 1},
    {WS_QC, 512, 0, QSC64, 2}, {WS_QC, 512, 256, QSC64, 2}, {WS_KC, 512, 0, 1.f, 2}, {WS_KC, 512, 256, 1.f, 2}, {WS_VC, 512, 0, 1.f, 1}, {WS_VC, 512, 256, 1.f, 1},
    {WS_VA, 128, -128, 1.f, 0} };
#define PIN16(x) asm volatile("" : "+v"(x[0][0]), "+v"(x[0][1]), "+v"(x[0][2]), "+v"(x[0][3]), "+v"(x[1][0]), "+v"(x[1][1]), "+v"(x[1][2]), "+v"(x[1][3]), \
                                   "+v"(x[2][0]), "+v"(x[2][1]), "+v"(x[2][2]), "+v"(x[2][3]), "+v"(x[3][0]), "+v"(x[3][1]), "+v"(x[3][2]), "+v"(x[3][3]))
struct EpiInProj {
    static constexpr bool IDEMP = true, PERM = true, HAS_MID = false;
    unsigned char* ws; float asc; int f8call; int t1, t2;
    __device__ __forceinline__ void operator()(const f32x4 (&acc_)[2][2][4][2], const pg8::Unit& u, int wr, int wc, int fr, int fq) const {
        f32x4 acc[2][2][4][2];
#pragma unroll
        for (int a_ = 0; a_ < 2; ++a_)
#pragma unroll
            for (int b_ = 0; b_ < 2; ++b_)
#pragma unroll
                for (int m_ = 0; m_ < 4; ++m_)
#pragma unroll
                    for (int n_ = 0; n_ < 2; ++n_) acc[a_][b_][m_][n_] = acc_[a_][b_][m_][n_] * asc;
        const int t = f8call ? tile_of_fp8(u.pn) : tile_of_bf16(u.pn); const int row0 = u.pm * 256 + wr * 64 + fr;
        if (t >= 20) {
            unsigned char* MG = ws + WS_MG; const int col0 = (t - 20) * 256 + wc * 64 + 16 * fq;
#pragma unroll
            for (int ai = 0; ai < 2; ++ai)
#pragma unroll
                for (int m = 0; m < 4; ++m) { unsigned char* rp = MG + (size_t)(row0 + ai * 128 + m * 16) * 6144 + col0; u32x4 w4;
#pragma unroll
                    for (int bj = 0; bj < 2; ++bj) { const f32x4 v0 = acc[ai][bj][m][0], v1 = acc[ai][bj][m][1]; u32x2 w; w.x = 0u; w.y = 0u;
#pragma unroll
                        for (int e = 0; e < 4; ++e) { w.x = __builtin_amdgcn_cvt_pk_u8_f32(fmaxf(__builtin_rintf(255.f * sigmoidf_(v0[e])), 1.f), e, w.x); w.y = __builtin_amdgcn_cvt_pk_u8_f32(fmaxf(__builtin_rintf(255.f * sigmoidf_(v1[e])), 1.f), e, w.y); }
                        if (bj == 0) { w4.x = w.x; w4.y = w.y; } else { w4.z = w.x; w4.w = w.y; } }
                    *(u32x4*)rp = w4; }
            return;
        }
        if (t == 19) {
            if (wc == 0) { float* GB = (float*)(ws + WS_GATEB);
#pragma unroll
                for (int ai = 0; ai < 2; ++ai)
#pragma unroll
                    for (int m = 0; m < 4; ++m) { float* rp = GB + (size_t)(row0 + ai * 128 + m * 16) * 32 + 8 * fq;
                        const f32x4 v0 = acc[ai][0][m][0], v1 = acc[ai][0][m][1];
                        *(f32x4*)rp = (f32x4){sigmoidf_(v0[0]), sigmoidf_(v0[1]), sigmoidf_(v0[2]), sigmoidf_(v0[3])};
                        *(f32x4*)(rp + 4) = (f32x4){sigmoidf_(v1[0]), sigmoidf_(v1[1]), sigmoidf_(v1[2]), sigmoidf_(v1[3])}; } }
            return;
        }
        bool d128, rope; bf16_t* dst; int ld, cb; float sc = 1.f; bool headmajor = false;
        if (t < 2)       { d128 = false; rope = true;  dst = (bf16_t*)(ws + WS_QA); ld = 512; cb = t * 256; sc = QSC64; }
        else if (t == 2) { d128 = false; rope = wc < 2; if (wc < 2) { dst = (bf16_t*)(ws + WS_KA); ld = 128; cb = 0; } else { dst = (bf16_t*)(ws + WS_VA); ld = 128; cb = -128; } }
        else if (t < 7)  { d128 = true;  rope = true;  dst = (bf16_t*)(ws + WS_QB); ld = 1024; cb = (t - 3) * 256; sc = QSC128; }
        else if (t == 7) { d128 = true;  rope = true;  dst = (bf16_t*)(ws + WS_KCB); ld = 128; cb = 0; headmajor = true; }
        else if (t == 8) { d128 = true;  rope = false; dst = (bf16_t*)(ws + WS_VCB); ld = 128; cb = 0; headmajor = true; }
        else if (t == 9) { d128 = true;  rope = true;  dst = (bf16_t*)(ws + WS_KSB); ld = 256; cb = 0; }
        else if (t == 10){ d128 = true;  rope = false; dst = (bf16_t*)(ws + WS_VSB); ld = 256; cb = 0; }
        else if (t == 11){ d128 = true;  rope = true;  dst = (bf16_t*)(ws + WS_KWB); ld = 256; cb = 0; }
        else if (t == 12){ d128 = true;  rope = false; dst = (bf16_t*)(ws + WS_VWB); ld = 256; cb = 0; }
        else if (t < 15) { d128 = false; rope = true;  dst = (bf16_t*)(ws + WS_QC); ld = 512; cb = (t - 13) * 256; sc = QSC64; }
        else if (t < 17) { d128 = false; rope = true;  dst = (bf16_t*)(ws + WS_KC); ld = 512; cb = (t - 15) * 256; }
        else             { d128 = true;  rope = false; dst = (bf16_t*)(ws + WS_VC); ld = 512; cb = (t - 17) * 256; }
        const int hw = d128 ? 128 : 64, hh = d128 ? (wc >> 1) : wc, i0 = (d128 ? 32 * (wc & 1) : 0) + 8 * fq;
        const f32x2* rt = d128 ? (const f32x2*)(ws + WS_ROPE128) : (const f32x2*)(ws + WS_ROPE64); const int rld = d128 ? 64 : 32;
#pragma unroll
        for (int ai = 0; ai < 2; ++ai)
#pragma unroll
            for (int m = 0; m < 4; ++m) {
                const int row = row0 + ai * 128 + m * 16;
                float x1[8], x2[8];
#pragma unroll
                for (int n = 0; n < 2; ++n)
#pragma unroll
                    for (int e = 0; e < 4; ++e) { x1[4 * n + e] = acc[ai][0][m][n][e]; x2[4 * n + e] = acc[ai][1][m][n][e]; }
                if (rope) {
                    const f32x4* rp = (const f32x4*)(rt + (size_t)row * rld + i0);
#pragma unroll
                    for (int k = 0; k < 4; ++k) { const f32x4 cs = rp[k];
                        { const float a = x1[2 * k], b = x2[2 * k]; x1[2 * k] = a * cs[0] - b * cs[1]; x2[2 * k] = b * cs[0] + a * cs[1]; }
                        { const float a = x1[2 * k + 1], b = x2[2 * k + 1]; x1[2 * k + 1] = a * cs[2] - b * cs[3]; x2[2 * k + 1] = b * cs[2] + a * cs[3]; } }
                }
                u32x4 w1, w2;
                w1.x = pk2(x1[0] * sc, x1[1] * sc); w1.y = pk2(x1[2] * sc, x1[3] * sc); w1.z = pk2(x1[4] * sc, x1[5] * sc); w1.w = pk2(x1[6] * sc, x1[7] * sc);
                w2.x = pk2(x2[0] * sc, x2[1] * sc); w2.y = pk2(x2[2] * sc, x2[3] * sc); w2.z = pk2(x2[4] * sc, x2[5] * sc); w2.w = pk2(x2[6] * sc, x2[7] * sc);
                size_t o;
                if (headmajor) { const int b = row >> 11, s = row & 2047; o = ((size_t)((b * 2 + hh) * 2048 + s)) * 128 + i0; }
                else o = (size_t)row * ld + cb + hh * hw + i0;
                *(u32x4*)(dst + o) = w1; *(u32x4*)(dst + o + hw / 2) = w2;
                asm volatile("" ::: "memory");
            }
    }
};

#ifndef F_F8
#define F_F8 1
#endif
constexpr float SM8 = 16.f;
struct EpiMerge {
    static constexpr bool IDEMP = false, PERM = true, HAS_MID = true;
    const unsigned char* MG; bf16_t* out; int t1, t2;
    static __device__ __forceinline__ void unpack8(float (&f)[8], const u32x2 a) {
        f[0] = (float)(a.x & 0xff); f[1] = (float)((a.x >> 8) & 0xff); f[2] = (float)((a.x >> 16) & 0xff); f[3] = (float)(a.x >> 24); f[4] = (float)(a.y & 0xff); f[5] = (float)((a.y >> 8) & 0xff); f[6] = (float)((a.y >> 16) & 0xff); f[7] = (float)(a.y >> 24); }
    __device__ __forceinline__ void mid(f32x4 (&acc)[2][2][4][2], const pg8::Unit& u, int t, int wr, int wc, int fr_, int fq) const {
        int fr = fr_; asm volatile("" : "+v"(fr));
        const int seg = (t == t1) ? 0 : 1; const int row0 = u.pm * 256 + wr * 64 + fr, col0 = u.pn * 256 + wc * 64 + 16 * fq;
        const unsigned off0 = (unsigned)row0 * 6144u + (unsigned)col0 + (unsigned)seg * 2048u;
        u32x4 g[2][4][2];
#pragma unroll
        for (int ai = 0; ai < 2; ++ai)
#pragma unroll
            for (int m = 0; m < 4; ++m) { const unsigned char* rp = MG + (off0 + (unsigned)(ai * 128 + m * 16) * 6144u); g[ai][m][0] = *(const u32x4*)rp; g[ai][m][1] = *(const u32x4*)(rp + 2048); }
        asm volatile("" : "+v"(g[0][0][0]), "+v"(g[0][0][1]), "+v"(g[0][1][0]), "+v"(g[0][1][1]), "+v"(g[0][2][0]), "+v"(g[0][2][1]), "+v"(g[0][3][0]), "+v"(g[0][3][1]),
                          "+v"(g[1][0][0]), "+v"(g[1][0][1]), "+v"(g[1][1][0]), "+v"(g[1][1][1]), "+v"(g[1][2][0]), "+v"(g[1][2][1]), "+v"(g[1][3][0]), "+v"(g[1][3][1]));
#pragma unroll
        for (int ai = 0; ai < 2; ++ai) {
#pragma unroll
            for (int m = 0; m < 4; ++m)
#pragma unroll
                for (int bj = 0; bj < 2; ++bj) { float f[8], d[8]; unpack8(f, bj ? (u32x2){g[ai][m][0].z, g[ai][m][0].w} : (u32x2){g[ai][m][0].x, g[ai][m][0].y}); unpack8(d, bj ? (u32x2){g[ai][m][1].z, g[ai][m][1].w} : (u32x2){g[ai][m][1].x, g[ai][m][1].y});
#pragma unroll
                    for (int k = 0; k < 8; ++k) f[k] = f[k] * __builtin_amdgcn_rcpf(d[k]);
                    f32x4& v0 = acc[ai][bj][m][0]; f32x4& v1 = acc[ai][bj][m][1];
                    v0[0] *= f[0]; v0[1] *= f[1]; v0[2] *= f[2]; v0[3] *= f[3]; v1[0] *= f[4]; v1[1] *= f[5]; v1[2] *= f[6]; v1[3] *= f[7]; }
        }
    }
    __device__ __forceinline__ void operator()(f32x4 (&acc)[2][2][4][2], const pg8::Unit& u, int wr, int wc, int fr_, int fq_) const {
        int fr = fr_, fq = fq_; asm volatile("" : "+v"(fr), "+v"(fq));
        const int row0 = u.pm * 256 + wr * 64 + fr, col0 = u.pn * 256 + wc * 32 + 8 * fq, gcol = u.pn * 256 + wc * 64 + 16 * fq;
        u32x4 g[4][2];
#pragma unroll
        for (int ai = 0; ai < 2; ++ai)
#pragma unroll
            for (int m = 0; m < 4; ++m) g[m][ai] = *(const u32x4*)(MG + (size_t)(row0 + ai * 128 + m * 16) * 6144 + gcol + 4096);
        asm volatile("" : "+v"(g[0][0]), "+v"(g[0][1]), "+v"(g[1][0]), "+v"(g[1][1]), "+v"(g[2][0]), "+v"(g[2][1]), "+v"(g[3][0]), "+v"(g[3][1]));
#pragma unroll
        for (int ai = 0; ai < 2; ++ai)
#pragma unroll
            for (int m = 0; m < 4; ++m) { bf16_t* op = out + (size_t)(row0 + ai * 128 + m * 16) * DM + col0; u32x4 w84;
#pragma unroll
                for (int bj = 0; bj < 2; ++bj) { float f[8]; unpack8(f, bj ? (u32x2){g[m][ai].z, g[m][ai].w} : (u32x2){g[m][ai].x, g[m][ai].y}); const f32x4 v0 = acc[ai][bj][m][0] * (1.f / 255.f), v1 = acc[ai][bj][m][1] * (1.f / 255.f);
                    if (F_F8) { u32x2 w8; w8.x = pk4_fp8(v0[0] * f[0] * SM8, v0[1] * f[1] * SM8, v0[2] * f[2] * SM8, v0[3] * f[3] * SM8); w8.y = pk4_fp8(v1[0] * f[4] * SM8, v1[1] * f[5] * SM8, v1[2] * f[6] * SM8, v1[3] * f[7] * SM8);
                        if (bj == 0) { w84.x = w8.x; w84.y = w8.y; } else { w84.z = w8.x; w84.w = w8.y; } }
                    else { u32x4 w; w.x = pk2(v0[0] * f[0], v0[1] * f[1]); w.y = pk2(v0[2] * f[2], v0[3] * f[3]); w.z = pk2(v1[0] * f[4], v1[1] * f[5]); w.w = pk2(v1[2] * f[6], v1[3] * f[7]); *(u32x4*)(op + bj * 128) = w; } }
                if (F_F8) *(u32x4*)((unsigned char*)out + (size_t)(row0 + ai * 128 + m * 16) * DM + gcol) = w84; }
    }
};

struct EpiResidual {
    static constexpr bool IDEMP = false, PERM = true, HAS_MID = false;
    bf16_t* xb; unsigned char* xt8; float* ssq; float asc; int t1, t2;
    __device__ __forceinline__ void operator()(const f32x4 (&acc)[2][2][4][2], const pg8::Unit& u, int wr, int wc, int fr_, int fq_) const {
        int fr = fr_, fq = fq_; asm volatile("" : "+v"(fr), "+v"(fq));
        const int col0 = u.pn * 256 + wc * 32 + 8 * fq;
#pragma unroll
        for (int ai = 0; ai < 2; ++ai) {
            u32x4 b[4][2];
#pragma unroll
            for (int m = 0; m < 4; ++m) {
                if (m == 0) {
#pragma unroll
                    for (int mm = 0; mm < 4; ++mm) { const size_t off = (size_t)(u.pm * 256 + ai * 128 + wr * 64 + mm * 16 + fr) * DM + col0;
#pragma unroll
                        for (int bj = 0; bj < 2; ++bj) b[mm][bj] = *(const u32x4*)(xb + off + bj * 128); }
                    asm volatile("" : "+v"(b[0][0]), "+v"(b[0][1]), "+v"(b[1][0]), "+v"(b[1][1]), "+v"(b[2][0]), "+v"(b[2][1]), "+v"(b[3][0]), "+v"(b[3][1]));
                }
                const int row = u.pm * 256 + ai * 128 + wr * 64 + m * 16 + fr; const size_t off = (size_t)row * DM + col0; float ss = 0.f; u32x4 w84;
#pragma unroll
                for (int bj = 0; bj < 2; ++bj) { const u32x4 bb = b[m][bj];
                    const f32x4 v0 = (f32x4){bf2f(bb.x & 0xffff), bf2f(bb.x >> 16), bf2f(bb.y & 0xffff), bf2f(bb.y >> 16)} + acc[ai][bj][m][0] * asc, v1 = (f32x4){bf2f(bb.z & 0xffff), bf2f(bb.z >> 16), bf2f(bb.w & 0xffff), bf2f(bb.w >> 16)} + acc[ai][bj][m][1] * asc;
                    u32x4 w; w.x = pk2(v0[0], v0[1]); w.y = pk2(v0[2], v0[3]); w.z = pk2(v1[0], v1[1]); w.w = pk2(v1[2], v1[3]); *(u32x4*)(xb + off + bj * 128) = w;
                    ss += ((v0[0] * v0[0] + v0[1] * v0[1]) + (v0[2] * v0[2] + v0[3] * v0[3])) + ((v1[0] * v1[0] + v1[1] * v1[1]) + (v1[2] * v1[2] + v1[3] * v1[3]));
                    if (xt8) { u32x2 w8; w8.x = pk4_fp8(v0[0] * SA8, v0[1] * SA8, v0[2] * SA8, v0[3] * SA8); w8.y = pk4_fp8(v1[0] * SA8, v1[1] * SA8, v1[2] * SA8, v1[3] * SA8); if (bj == 0) { w84.x = w8.x; w84.y = w8.y; } else { w84.z = w8.x; w84.w = w8.y; } } }
                if (xt8) { *(u32x2*)(xt8 + off) = (u32x2){w84.x, w84.y}; *(u32x2*)(xt8 + off + 128) = (u32x2){w84.z, w84.w}; }
                ss += __shfl_xor(ss, 16); ss += __shfl_xor(ss, 32); if (fq == 0) ssq[(size_t)row * 32 + u.pn * 4 + wc] = ss;
            }
        }
    }
};

struct EpiXq {
    static constexpr bool IDEMP = false, PERM = true, HAS_MID = false;
    bf16_t* QX; bf16_t* KVM; const LAS float* rstdl; int t1, t2;
    __device__ __forceinline__ void operator()(const f32x4 (&acc)[2][2][4][2], const pg8::Unit& u, int wr, int wc, int fr_, int fq_) const {
        int fr = fr_, fq = fq_; asm volatile("" : "+v"(fr), "+v"(fq));
        bf16_t* base; int ld; float sc; int rowb, colb; int pnv = u.pn; asm volatile("" : "+s"(pnv));
        if (pnv < 2) { base = QX; ld = 512; sc = QSC128; rowb = u.pm * 256; colb = u.pn * 256; } else { base = KVM; ld = 1024; sc = 1.f; rowb = (u.pm - 64) * 256; colb = (u.pn - 2) * 256; }
        asm volatile("" : "+v"(sc));
#pragma unroll
        for (int ai = 0; ai < 2; ++ai)
#pragma unroll
            for (int m = 0; m < 4; ++m) { bf16_t* rp = base + (size_t)(rowb + ai * 128 + wr * 64 + m * 16 + fr) * ld + colb + wc * 32 + 8 * fq; const float scr_ = (pnv < 2) ? sc * rstdl[ai * 128 + wr * 64 + m * 16 + fr] : sc;
#pragma unroll
                for (int bj = 0; bj < 2; ++bj) { const f32x4 v0 = acc[ai][bj][m][0] * scr_, v1 = acc[ai][bj][m][1] * scr_; u32x4 w; w.x = pk2(v0[0], v0[1]); w.y = pk2(v0[2], v0[3]); w.z = pk2(v1[0], v1[1]); w.w = pk2(v1[2], v1[3]);
                    *(u32x4*)(rp + bj * 128) = w; }
                asm volatile("" ::: "memory"); }
    }
};

#ifndef MOE_F8_FROM
#define MOE_F8_FROM 0
#endif
#define MOE_F8(l) ((l) >= MOE_F8_FROM)
constexpr float SH8 = 16.f;
struct EpiMoeUp {
    static constexpr bool IDEMP = false, PERM = true, HAS_MID = false;
    bf16_t* H; float asc; int f8; const float* rstd; const int* tok; const volatile LAS int* tab; int t1, t2;
    __device__ __forceinline__ void operator()(const f32x4 (&acc)[2][2][4][2], const pg8::Unit& u, int wr, int wc, int fr_, int fq_) const {
        int fr = fr_, fq = fq_; asm volatile("" : "+v"(fr), "+v"(fq));
        const int pnl = u.pn & 7, n_e = __builtin_amdgcn_readfirstlane(tab[NEXP + 1 + u.e]);
        float rs[2][4];
#pragma unroll
        for (int ai = 0; ai < 2; ++ai)
#pragma unroll
            for (int m = 0; m < 4; ++m) { const int slot = u.r * 256 + ai * 128 + wr * 64 + m * 16 + fr; rs[ai][m] = (slot < n_e) ? rstd[u.e * NTOK + slot] * asc : 0.f; }
#pragma unroll
        for (int ai = 0; ai < 2; ++ai)
#pragma unroll
            for (int m = 0; m < 4; ++m) { const size_t eo = (size_t)(u.pm * 256 + ai * 128 + wr * 64 + m * 16 + fr) * DFF + pnl * 128 + wc * 32 + 8 * fq; float h[8];
#pragma unroll
                for (int n = 0; n < 2; ++n)
#pragma unroll
                    for (int e = 0; e < 4; ++e) { const float gv = acc[ai][0][m][n][e] * rs[ai][m], uv = acc[ai][1][m][n][e] * rs[ai][m]; h[4 * n + e] = gv * sigmoidf_(gv) * uv; }
                if (f8) { u32x2 w8; w8.x = pk4_fp8(h[0] * SH8, h[1] * SH8, h[2] * SH8, h[3] * SH8); w8.y = pk4_fp8(h[4] * SH8, h[5] * SH8, h[6] * SH8, h[7] * SH8); *(u32x2*)((unsigned char*)H + eo) = w8; }
                else { u32x4 w; w.x = pk2(h[0], h[1]); w.y = pk2(h[2], h[3]); w.z = pk2(h[4], h[5]); w.w = pk2(h[6], h[7]); *(u32x4*)(H + eo) = w; }
                asm volatile("" ::: "memory"); }
    }
};

struct EpiMoeDown {
    static constexpr bool IDEMP = false, PERM = true, HAS_MID = false;
    bf16_t* Y; float asc; int t1, t2;
    __device__ __forceinline__ void operator()(const f32x4 (&acc)[2][2][4][2], const pg8::Unit& u, int wr, int wc, int fr_, int fq_) const {
        int fr = fr_, fq = fq_; asm volatile("" : "+v"(fr), "+v"(fq));
        const int pnl = u.pn & 7;
#pragma unroll
        for (int ai = 0; ai < 2; ++ai)
#pragma unroll
            for (int m = 0; m < 4; ++m) { bf16_t* rp = Y + (size_t)(u.pm * 256 + ai * 128 + wr * 64 + m * 16 + fr) * DM + pnl * 256 + wc * 32 + 8 * fq;
#pragma unroll
                for (int bj = 0; bj < 2; ++bj) { const f32x4 v0 = acc[ai][bj][m][0] * asc, v1 = acc[ai][bj][m][1] * asc; u32x4 w; w.x = pk2(v0[0], v0[1]); w.y = pk2(v0[2], v0[3]); w.z = pk2(v1[0], v1[1]); w.w = pk2(v1[2], v1[3]);
                    *(u32x4*)(rp + bj * 128) = w; }
                asm volatile("" ::: "memory"); }
    }
};

#ifndef QK_SB
#define QK_SB 0
#endif
#ifndef PV_SB
#define PV_SB 0
#endif
constexpr int ATT_STAGE = 32768;
constexpr int ATT_X = 65536;

template <int DQK> __device__ __forceinline__ void dma_k(LAS unsigned char* dst, const bf16_t* src, int ld, int wid, int lane) {
    constexpr int NC = DQK / 8;
    const bf16_t* rowp = src + (size_t)lane * ld;
#pragma unroll
    for (int ii0 = 0; ii0 < NC / 8; ++ii0) { const int c = wid + 8 * ii0;
        __builtin_amdgcn_global_load_lds((const unsigned*)(rowp + c * 8), (LAS unsigned*)(dst + c * 1024), 16, 0, 0); }
}
template <int DV> __device__ __forceinline__ void dma_v(LAS unsigned char* dst, const bf16_t* src, int ld, int wid, int lane) {
    constexpr int NI = DV / 8;
    const bf16_t* lp = src + (size_t)(lane >> 2) * ld + (lane & 3) * 8;
#pragma unroll
    for (int ii0 = 0; ii0 < NI / 8; ++ii0) { const int ii = wid + 8 * ii0, dblk = ii >> 2, kgrp = ii & 3;
        __builtin_amdgcn_global_load_lds((const unsigned*)(lp + (size_t)(16 * kgrp) * ld + dblk * 32), (LAS unsigned*)(dst + ii * 1024), 16, 0, 0); }
}
template <int DQK> __device__ __forceinline__ void qk_tile(f32x16& p0, f32x16& p1, const LAS unsigned char* Kt, const bf16x8* q, int r32, int hi) {
    p0 = (f32x16){}; p1 = (f32x16){};
    const LAS unsigned char* kb = Kt + hi * 1024 + r32 * 16;
    constexpr int NK = DQK / 16;
    bf16x8 a0[NK], a1[NK];
#pragma unroll
    for (int ks = 0; ks < NK; ++ks) { a0[ks] = *(const LAS bf16x8*)(kb + ks * 2048); a1[ks] = *(const LAS bf16x8*)(kb + ks * 2048 + 512); }
#pragma unroll
    for (int ks = 0; ks < NK; ++ks) { p0 = __builtin_amdgcn_mfma_f32_32x32x16_bf16(a0[ks], q[ks], p0, 0, 0, 0); p1 = __builtin_amdgcn_mfma_f32_32x32x16_bf16(a1[ks], q[ks], p1, 0, 0, 0); }
    __builtin_amdgcn_sched_group_barrier(0x100, 4, 0);
#pragma unroll
    for (int i = 0; i < NK - 2; ++i) { __builtin_amdgcn_sched_group_barrier(0x008, 2, 0); __builtin_amdgcn_sched_group_barrier(0x100, 2, 0); }
    __builtin_amdgcn_sched_group_barrier(0x008, 4, 0);
}
__device__ __forceinline__ float xhalf_max(float v) { auto rr = __builtin_amdgcn_permlane32_swap(__float_as_uint(v), __float_as_uint(v), false, false); return fmaxf(__uint_as_float(rr[0]), __uint_as_float(rr[1])); }
__device__ __forceinline__ float xhalf_sum(float v) { auto rr = __builtin_amdgcn_permlane32_swap(__float_as_uint(v), __float_as_uint(v), false, false); return __uint_as_float(rr[0]) + __uint_as_float(rr[1]); }
__device__ __forceinline__ bf16x8 pack8(const f32x16& p, int b) { u32x4 w; w.x = pk2(p[b], p[b + 1]); w.y = pk2(p[b + 2], p[b + 3]); w.z = pk2(p[b + 4], p[b + 5]); w.w = pk2(p[b + 6], p[b + 7]); return __builtin_bit_cast(bf16x8, w); }
__device__ __forceinline__ v4i16_t vtr(const LAS unsigned char* p) { return __builtin_amdgcn_ds_read_tr16_b64_v4i16((LAS v4i16_t*)p); }

template <int DV> __device__ __forceinline__ void pv_tile(f32x16* o, const LAS unsigned char* Vt, const bf16x8* pw, int lane) {
    const int hi = lane >> 5, cg = (lane >> 4) & 1, q = (lane & 15) >> 2, p = lane & 3;
    const LAS unsigned char* vb = Vt + (4 * hi + q) * 64 + 32 * cg + 8 * p;
    constexpr int NF = DV / 32 * 4;
    v4i16_t lo[NF], h8[NF];
#pragma unroll
    for (int f = 0; f < NF; ++f) { lo[f] = vtr(vb + f * 1024); h8[f] = vtr(vb + f * 1024 + 512); }
#pragma unroll
    for (int f = 0; f < NF; ++f) { const bf16x8 vf = (bf16x8){lo[f][0], lo[f][1], lo[f][2], lo[f][3], h8[f][0], h8[f][1], h8[f][2], h8[f][3]};
        o[f >> 2] = __builtin_amdgcn_mfma_f32_32x32x16_bf16(vf, pw[f & 3], o[f >> 2], 0, 0, 0); }
    __builtin_amdgcn_sched_group_barrier(0x100, 6, 0);
#pragma unroll
    for (int i = 0; i < NF - 3; ++i) { __builtin_amdgcn_sched_group_barrier(0x008, 1, 0); __builtin_amdgcn_sched_group_barrier(0x100, 2, 0); }
    __builtin_amdgcn_sched_group_barrier(0x008, 3, 0);
}
__device__ __forceinline__ float max3f_(float a, float b, float c) { return fmaxf(fmaxf(a, b), c); }
template <int DV> __device__ __forceinline__ void softmax_pv(f32x16* o, float& m, float& l, f32x16& p0, f32x16& p1, const LAS unsigned char* Vt, int lane) {
    float ra = max3f_(p0[0], p0[1], p1[0]), rb = max3f_(p0[2], p0[3], p1[1]); ra = max3f_(ra, p1[2], p1[3]);
#pragma unroll
    for (int r = 4; r < 16; r += 4) { ra = max3f_(ra, p0[r], p0[r + 1]); rb = max3f_(rb, p0[r + 2], p0[r + 3]); ra = max3f_(ra, p1[r], p1[r + 1]); rb = max3f_(rb, p1[r + 2], p1[r + 3]); }
    float rm = xhalf_max(fmaxf(ra, rb));
    if (!__all(m == 0.f)) { rm -= m;
#pragma unroll
        for (int r = 0; r < 16; ++r) { p0[r] -= m; p1[r] -= m; } }
    if (__any(rm > 8.f)) { const float dl = fmaxf(rm, 0.f), alpha = __builtin_amdgcn_exp2f(-dl); m += dl; l *= alpha;
#pragma unroll
        for (int r = 0; r < 16; ++r) { p0[r] -= dl; p1[r] -= dl; }
#pragma unroll
        for (int dt = 0; dt < DV / 32; ++dt) o[dt] = o[dt] * alpha; }
    float ps = 0.f, ps2 = 0.f;
#pragma unroll
    for (int r = 0; r < 16; ++r) { p0[r] = __builtin_amdgcn_exp2f(p0[r]); p1[r] = __builtin_amdgcn_exp2f(p1[r]); ps += p0[r]; ps2 += p1[r]; }
    l += ps + ps2;
    bf16x8 pw[4]; pw[0] = pack8(p0, 0); pw[1] = pack8(p0, 8); pw[2] = pack8(p1, 0); pw[3] = pack8(p1, 8);
    pv_tile<DV>(o, Vt, pw, lane);
}
__device__ __forceinline__ int crow(int r, int hi) { return (r & 3) + 8 * (r >> 2) + 4 * hi; }
#define ATT_SYNC() do { asm volatile("s_waitcnt vmcnt(0)" ::: "memory"); __syncthreads(); } while (0)

template <int DQK, int DV, int NK, class MaskF>
__device__ __forceinline__ void attn_stream(LAS unsigned char* lds, unsigned tm, const bf16_t* Kg, int ldk, int kstride2, const bf16_t* Vg, int ldv, int ksel,
                                            const bf16x8* q, f32x16* o, float& m, float& l, const MaskF& mask, int wid, int lane) {
    const int r32 = lane & 31, hi = lane >> 5;
    if (tm == 0u) return;
    int j = __builtin_ctz(tm); tm &= tm - 1; int buf = 0;
#pragma unroll
    for (int k = 0; k < NK; ++k) dma_k<DQK>(lds + k * (64 * DQK * 2), Kg + (size_t)(64 * j) * ldk + k * kstride2, ldk, wid, lane);
    dma_v<DV>(lds + 16384, Vg + (size_t)(64 * j) * ldv, ldv, wid, lane);
    for (;;) {
        ATT_SYNC();
        int jn = -1;
        if (tm) { jn = __builtin_ctz(tm); tm &= tm - 1; LAS unsigned char* nb = lds + (buf ^ 1) * ATT_STAGE;
#pragma unroll
            for (int k = 0; k < NK; ++k) dma_k<DQK>(nb + k * (64 * DQK * 2), Kg + (size_t)(64 * jn) * ldk + k * kstride2, ldk, wid, lane);
            dma_v<DV>(nb + 16384, Vg + (size_t)(64 * jn) * ldv, ldv, wid, lane); }
        const LAS unsigned char* cb = lds + buf * ATT_STAGE;
        f32x16 p0, p1;
        qk_tile<DQK>(p0, p1, cb + ksel * (64 * DQK * 2), q, r32, hi);
        mask(p0, p1, j);
        softmax_pv<DV>(o, m, l, p0, p1, cb + 16384, lane);
        if (jn < 0) break;
        j = jn; buf ^= 1;
    }
    __syncthreads();
}
template <int DQK> __device__ __forceinline__ void load_q(bf16x8* q, const bf16_t* Qrow, int hi) {
#pragma unroll
    for (int ks = 0; ks < DQK / 16; ++ks) q[ks] = *(const bf16x8*)(Qrow + 16 * ks + 8 * hi);
}
__device__ __forceinline__ void store16_pair(bf16_t* rowp, int hi, u32x2 a, u32x2 b) {
    auto r0 = __builtin_amdgcn_permlane32_swap(a.x, b.x, false, false); auto r1 = __builtin_amdgcn_permlane32_swap(a.y, b.y, false, false);
    *(u32x4*)(rowp + (hi ? 8 : 0)) = (u32x4){r0[0], r1[0], r0[1], r1[1]};
}
template <int DV> __device__ __forceinline__ void store_o(bf16_t* Orow, const f32x16* o, float scale, int hi) {
#pragma unroll
    for (int dt = 0; dt < DV / 32; ++dt)
#pragma unroll
        for (int kp = 0; kp < 2; ++kp) { u32x2 a, b2; const int r0 = 8 * kp;
            a.x = pk2(o[dt][r0] * scale, o[dt][r0 + 1] * scale); a.y = pk2(o[dt][r0 + 2] * scale, o[dt][r0 + 3] * scale);
            b2.x = pk2(o[dt][r0 + 4] * scale, o[dt][r0 + 5] * scale); b2.y = pk2(o[dt][r0 + 6] * scale, o[dt][r0 + 7] * scale);
            store16_pair(Orow + 32 * dt + 16 * kp, hi, a, b2); }
}

__device__ __forceinline__ void mask_apply(f32x16& p0, f32x16& p1, int d, int lo) {
#pragma unroll
    for (int r = 0; r < 16; ++r) { const int C = (r & 3) + 8 * (r >> 2); if (C > d || C <= lo) p0[r] = -INFINITY; if (C + 32 > d || C + 32 <= lo) p1[r] = -INFINITY; }
}
struct MaskWin { int qrow, W, hi; __device__ __forceinline__ void operator()(f32x16& p0, f32x16& p1, int j) const {
    const int qmin = __builtin_amdgcn_readfirstlane(qrow), kb = 64 * j;
    if (kb + 63 <= qmin && kb > qmin + 31 - W) return;
    const int d = qrow - kb - 4 * hi; mask_apply(p0, p1, d, d - W); } };
struct MaskNone { __device__ __forceinline__ void operator()(f32x16&, f32x16&, int) const {} };
struct MaskSel { int qrow; unsigned sel; int hi; __device__ __forceinline__ void operator()(f32x16& p0, f32x16& p1, int j) const {
    const int qmin = __builtin_amdgcn_readfirstlane(qrow), kb = 64 * j; const bool on = (sel >> j) & 1u;
    if (kb + 63 <= qmin && __all(on)) return;
    const int d = on ? (qrow - kb - 4 * hi) : -1; mask_apply(p0, p1, d, -(1 << 30)); } };

__device__ __forceinline__ void attn_item_swa(LAS unsigned char* lds, unsigned char* ws, const float* sinks, int b, int kvh, int qb, int wid, int lane) {
    const int r32 = lane & 31, hi = lane >> 5, head = kvh * 4 + (wid >> 1), qrow = qb * 64 + 32 * (wid & 1) + r32; const size_t tok = (size_t)b * SEQ + qrow;
    bf16x8 q[4]; load_q<64>(q, (const bf16_t*)(ws + WS_QA) + tok * 512 + head * 64, hi);
    f32x16 o[2]; o[0] = (f32x16){}; o[1] = (f32x16){};
    float m = sinks[head] * LOG2E, l = hi == 0 ? 1.f : 0.f;
    unsigned tm = 0; for (int j = (qb >= 2 ? qb - 2 : 0); j <= qb; ++j) tm |= 1u << j;
    MaskWin mk{qrow, 128, hi};
    attn_stream<64, 64, 1>(lds, tm, (const bf16_t*)(ws + WS_KA) + (size_t)b * SEQ * 128 + kvh * 64, 128, 0, (const bf16_t*)(ws + WS_VA) + (size_t)b * SEQ * 128 + kvh * 64, 128, 0, q, o, m, l, mk, wid, lane);
    l = xhalf_sum(l);
    store_o<64>((bf16_t*)(ws + WS_OCAT) + tok * DM + head * 64, o, 1.f / l, hi);
}

__device__ __forceinline__ void attn_item_cross(LAS unsigned char* lds, unsigned char* ws, int b, int h, int qb, int wid, int lane) {
    const int r32 = lane & 31, hi = lane >> 5, qrow = qb * 256 + 32 * wid + r32; const size_t tok = (size_t)b * SEQ + qrow;
    bf16x8 q[8]; load_q<128>(q, (const bf16_t*)(ws + WS_QX) + tok * 512 + h * 128, hi);
    f32x16 o[4]; o[0] = (f32x16){}; o[1] = (f32x16){}; o[2] = (f32x16){}; o[3] = (f32x16){};
    float m = 0.f, l = 0.f; MaskNone mk;
    const bf16_t* kv = (const bf16_t*)(ws + WS_KVM) + (size_t)b * NMEM * 1024 + h * 128;
    attn_stream<128, 128, 1>(lds, 0xFu, kv, 1024, 0, kv + 512, 1024, 0, q, o, m, l, mk, wid, lane);
    l = xhalf_sum(l);
    store_o<128>((bf16_t*)(ws + WS_OX) + tok * 512 + h * 128, o, 1.f / l, hi);
}

__device__ __forceinline__ void attn_item_diff(LAS unsigned char* lds, unsigned char* ws, const float* g_sub, float lam, float lambda_init, int b, int h, int qb, int wid, int lane) {
    const int r32 = lane & 31, hi = lane >> 5, comp = wid >> 2, qrow = qb * 128 + 32 * (wid & 3) + r32; const size_t tok = (size_t)b * SEQ + qrow;
    bf16x8 q[4]; load_q<64>(q, (const bf16_t*)(ws + WS_QC) + tok * 512 + (h * 2 + comp) * 64, hi);
    f32x16 o[4]; o[0] = (f32x16){}; o[1] = (f32x16){}; o[2] = (f32x16){}; o[3] = (f32x16){};
    float m = 0.f, l = 0.f;
    const int nt = 2 * qb + 2; const unsigned tm = (nt >= 32) ? 0xFFFFFFFFu : ((1u << nt) - 1u);
    MaskWin mk{qrow, 1 << 28, hi};
    attn_stream<64, 128, 2>(lds, tm, (const bf16_t*)(ws + WS_KC) + (size_t)b * SEQ * 512 + h * 128, 512, 64, (const bf16_t*)(ws + WS_VC) + (size_t)b * SEQ * 512 + h * 128, 512, comp, q, o, m, l, mk, wid, lane);
    l = xhalf_sum(l); const float il = 1.f / l;
    LAS float* xp = (LAS float*)(lds + ATT_X) + (wid & 3) * 4096 + lane;
    if (comp == 1) {
#pragma unroll
        for (int dt = 0; dt < 4; ++dt)
#pragma unroll
            for (int r = 0; r < 16; ++r) xp[(dt * 16 + r) * 64] = o[dt][r] * il;
    }
    __syncthreads();
    if (comp == 0) {
        float ss = 0.f;
#pragma unroll
        for (int dt = 0; dt < 4; ++dt)
#pragma unroll
            for (int r = 0; r < 16; ++r) { const float v = o[dt][r] * il - lam * xp[(dt * 16 + r) * 64]; o[dt][r] = v; ss += v * v; }
        ss = xhalf_sum(ss);
        const float rs = rsqrtf(ss * (1.f / 128.f) + EPS) * (1.f - lambda_init); const float* gsb = g_sub + 4 * hi;
#pragma unroll
        for (int dt = 0; dt < 4; ++dt)
#pragma unroll
            for (int r = 0; r < 16; ++r) o[dt][r] *= gsb[32 * dt + (r & 3) + 8 * (r >> 2)];
        store_o<128>((bf16_t*)(ws + WS_OCAT) + tok * DM + 1536 + h * 128, o, rs, hi);
    }
    __syncthreads();
}

__device__ __forceinline__ void attn_item_nsa(LAS unsigned char* lds, unsigned char* ws, int layer, int b, int g, int qb, int wid, int lane) {
    const int tid = wid * 64 + lane, r32 = lane & 31, hi = lane >> 5, hs = wid >> 1, head = g * 4 + hs, ql = 32 * (wid & 1) + r32, qrow = qb * 64 + ql; const size_t tok = (size_t)b * SEQ + qrow;
    bf16x8 q[8]; load_q<128>(q, (const bf16_t*)(ws + WS_QB) + tok * 1024 + head * 128, hi);
    const float* gb = (const float*)(ws + WS_GATEB) + tok * 32 + head * 3; const float g0 = gb[0], g1 = gb[1], g2 = gb[2];
    LAS float* Gs = (LAS float*)(lds + ATT_X);
    LAS float* Es = Gs + 4 * 32 * 64;
    LAS float* IMP = (LAS float*)(lds);
    LAS unsigned* SEL = (LAS unsigned*)(lds + 16384);
    u32x4 opk[8];
    {
        const bf16_t* kc = (const bf16_t*)(ws + WS_KCMP + (size_t)layer * 512 * 1024) + (size_t)(b * 2 + g) * 128 * 128; const bf16_t* vc = (const bf16_t*)(ws + WS_VCMP + (size_t)layer * 512 * 1024) + (size_t)(b * 2 + g) * 128 * 128;
        dma_k<128>(lds, kc, 128, wid, lane); dma_v<128>(lds + 16384, vc, 128, wid, lane);
        dma_k<128>(lds + ATT_STAGE, kc + 64 * 128, 128, wid, lane); dma_v<128>(lds + ATT_STAGE + 16384, vc + 64 * 128, 128, wid, lane);
        ATT_SYNC();
        f32x16 s[4];
        qk_tile<128>(s[0], s[1], lds, q, r32, hi); qk_tile<128>(s[2], s[3], lds + ATT_STAGE, q, r32, hi);
        float rm = -1e30f; const int dcm = qrow - 64 * hi - 31;
#pragma unroll
        for (int t = 0; t < 4; ++t)
#pragma unroll
            for (int r = 0; r < 16; ++r) { const int C16 = 512 * t + 16 * ((r & 3) + 8 * (r >> 2)); bool ok = (C16 <= dcm); if (t == 3 && r == 15) ok = ok && (hi == 0);
                s[t][r] = ok ? s[t][r] : -INFINITY; rm = fmaxf(rm, s[t][r]); }
        rm = xhalf_max(rm); float ps = 0.f;
#pragma unroll
        for (int t = 0; t < 4; ++t)
#pragma unroll
            for (int r = 0; r < 16; ++r) { s[t][r] = __builtin_amdgcn_exp2f(s[t][r] - rm); ps += s[t][r]; }
        ps = xhalf_sum(ps); const float inv = ps > 0.f ? 1.f / ps : 0.f;
        LAS float* gsp = Gs + (hs * 32 + hi) * 64 + ql;
#pragma unroll
        for (int t = 0; t < 4; ++t) {
#pragma unroll
            for (int r = 0; r < 16; ++r) s[t][r] *= inv;
#pragma unroll
            for (int r4 = 0; r4 < 4; ++r4) { gsp[(8 * t + 2 * r4) * 64] = (s[t][4 * r4] + s[t][4 * r4 + 1]) + (s[t][4 * r4 + 2] + s[t][4 * r4 + 3]); gsp[8192 + (8 * t + 2 * r4) * 64] = s[t][4 * r4 + 3]; }
        }
        f32x16 o[4]; o[0] = (f32x16){}; o[1] = (f32x16){}; o[2] = (f32x16){}; o[3] = (f32x16){};
        { bf16x8 pw[4]; pw[0] = pack8(s[0], 0); pw[1] = pack8(s[0], 8); pw[2] = pack8(s[1], 0); pw[3] = pack8(s[1], 8); pv_tile<128>(o, lds + 16384, pw, lane);
          pw[0] = pack8(s[2], 0); pw[1] = pack8(s[2], 8); pw[2] = pack8(s[3], 0); pw[3] = pack8(s[3], 8); pv_tile<128>(o, lds + ATT_STAGE + 16384, pw, lane); }
#pragma unroll
        for (int dt = 0; dt < 4; ++dt) { opk[2 * dt].x = pk2(o[dt][0] * g0, o[dt][1] * g0); opk[2 * dt].y = pk2(o[dt][2] * g0, o[dt][3] * g0); opk[2 * dt].z = pk2(o[dt][4] * g0, o[dt][5] * g0); opk[2 * dt].w = pk2(o[dt][6] * g0, o[dt][7] * g0);
            opk[2 * dt + 1].x = pk2(o[dt][8] * g0, o[dt][9] * g0); opk[2 * dt + 1].y = pk2(o[dt][10] * g0, o[dt][11] * g0); opk[2 * dt + 1].z = pk2(o[dt][12] * g0, o[dt][13] * g0); opk[2 * dt + 1].w = pk2(o[dt][14] * g0, o[dt][15] * g0); }
    }
    __syncthreads();
    if (tid == 0) SEL[64] = 0u;
#pragma unroll
    for (int it = 0; it < 4; ++it) { const int idx = tid + 512 * it, qq = idx & 63, j = idx >> 6;
        float v = 0.f;
#pragma unroll
        for (int h4 = 0; h4 < 4; ++h4) { v += Gs[(h4 * 32 + j) * 64 + qq]; if (j > 0) v += Es[(h4 * 32 + j - 1) * 64 + qq]; }
        const bool future = j > qb, forced = (j == 0) || (j == qb) || (j == qb - 1);
        IMP[qq * 33 + j] = future ? -1.0f : (forced ? 1e6f : v); }
    __syncthreads();
#pragma unroll
    for (int it = 0; it < 4; ++it) { const int idx = tid + 512 * it, qq = idx >> 5, j = idx & 31; const float vj = IMP[qq * 33 + j]; int cnt = 0;
#pragma unroll 8
        for (int i = 0; i < 32; ++i) { const float vi = IMP[qq * 33 + i]; cnt += (vi > vj || (vi == vj && i < j)) ? 1 : 0; }
        const unsigned long long bal = __ballot(cnt < 8);
        const unsigned mine = (lane < 32) ? (unsigned)bal : (unsigned)(bal >> 32);
        if ((lane & 31) == 0) { SEL[qq] = mine; atomicOr((unsigned*)&SEL[64], mine); } }
    __syncthreads();
    const unsigned sel = SEL[ql]; const unsigned live = (qb >= 31) ? 0xFFFFFFFFu : ((1u << (qb + 1)) - 1u); const unsigned un = SEL[64] & live;
    LAS unsigned* xo = (LAS unsigned*)(lds + ATT_X) + wid * 2048 + lane;
#pragma unroll
    for (int k = 0; k < 8; ++k) { xo[(4 * k) * 64] = opk[k].x; xo[(4 * k + 1) * 64] = opk[k].y; xo[(4 * k + 2) * 64] = opk[k].z; xo[(4 * k + 3) * 64] = opk[k].w; }
    __syncthreads();
    load_q<128>(q, (const bf16_t*)(ws + WS_QB) + tok * 1024 + head * 128, hi);
    {
        f32x16 o[4]; o[0] = (f32x16){}; o[1] = (f32x16){}; o[2] = (f32x16){}; o[3] = (f32x16){};
        float m = 0.f, l = 0.f; MaskSel mk{qrow, sel, hi};
        attn_stream<128, 128, 1>(lds, un, (const bf16_t*)(ws + WS_KSB) + (size_t)b * SEQ * 256 + g * 128, 256, 0, (const bf16_t*)(ws + WS_VSB) + (size_t)b * SEQ * 256 + g * 128, 256, 0, q, o, m, l, mk, wid, lane);
        l = xhalf_sum(l); const float sc = g1 / l;
#pragma unroll
        for (int dt = 0; dt < 4; ++dt)
#pragma unroll
            for (int k = 0; k < 8; ++k) { const unsigned w = xo[(8 * dt + k) * 64]; xo[(8 * dt + k) * 64] = pk2(bf2f(w & 0xffff) + o[dt][2 * k] * sc, bf2f(w >> 16) + o[dt][2 * k + 1] * sc); }
    }
    {
        f32x16 o[4]; o[0] = (f32x16){}; o[1] = (f32x16){}; o[2] = (f32x16){}; o[3] = (f32x16){};
        float m = 0.f, l = 0.f; MaskWin mk{qrow, 512, hi};
        unsigned tm = 0; for (int j = (qb >= 8 ? qb - 8 : 0); j <= qb; ++j) tm |= 1u << j;
        attn_stream<128, 128, 1>(lds, tm, (const bf16_t*)(ws + WS_KWB) + (size_t)b * SEQ * 256 + g * 128, 256, 0, (const bf16_t*)(ws + WS_VWB) + (size_t)b * SEQ * 256 + g * 128, 256, 0, q, o, m, l, mk, wid, lane);
        l = xhalf_sum(l); const float sc = g2 / l;
        bf16_t* Orow = (bf16_t*)(ws + WS_OCAT) + tok * DM + 512 + head * 128;
#pragma unroll
        for (int dt = 0; dt < 4; ++dt)
#pragma unroll
            for (int kp = 0; kp < 2; ++kp) { u32x2 ab[2];
#pragma unroll
                for (int h2 = 0; h2 < 2; ++h2) { const int r4 = 2 * kp + h2; const unsigned w0 = xo[(8 * dt + 2 * r4) * 64], w1 = xo[(8 * dt + 2 * r4 + 1) * 64];
                    ab[h2].x = pk2(bf2f(w0 & 0xffff) + o[dt][4 * r4] * sc, bf2f(w0 >> 16) + o[dt][4 * r4 + 1] * sc); ab[h2].y = pk2(bf2f(w1 & 0xffff) + o[dt][4 * r4 + 2] * sc, bf2f(w1 >> 16) + o[dt][4 * r4 + 3] * sc); }
                store16_pair(Orow + 32 * dt + 16 * kp, hi, ab[0], ab[1]); }
        __syncthreads();
    }
}

__device__ __forceinline__ void compress_item(LAS unsigned char* lds, unsigned char* ws, int layer, int kv, int bg, int rg, int wid, int lane) {
    const int r32 = lane & 31, hi = lane >> 5, ntile = wid & 3, khalf = wid >> 2;
    const bf16_t* src = (const bf16_t*)(ws + (kv ? WS_VCB : WS_KCB)) + (size_t)bg * SEQ * 128 + (size_t)(32 * rg + r32) * 2048 + khalf * 2048 + 8 * hi;
    const bf16_t* w1 = (const bf16_t*)(ws + WS_PHI1) + (size_t)((layer * 2 + kv) * 128 + 32 * ntile + r32) * 4096 + khalf * 2048 + 8 * hi;
    f32x16 acc = (f32x16){};
#pragma unroll 16
    for (int ks = 0; ks < 128; ++ks) { const bf16x8 a = *(const bf16x8*)(src + 16 * ks), bw = *(const bf16x8*)(w1 + 16 * ks); acc = __builtin_amdgcn_mfma_f32_32x32x16_bf16(a, bw, acc, 0, 0, 0); }
    LAS float* RED = (LAS float*)lds;
    LAS bf16_t* HID = (LAS bf16_t*)(lds + 16384);
    if (khalf == 1) {
#pragma unroll
        for (int r = 0; r < 16; ++r) RED[(ntile * 16 + r) * 64 + lane] = acc[r]; }
    __syncthreads();
    if (khalf == 0) { const f32x4 b4 = ((const f32x4*)(ws + WS_CBIAS))[(layer * 2 + kv) * 128 + 32 * ntile + r32]; const float bias = (b4[0] + b4[1]) + (b4[2] + b4[3]);
#pragma unroll
        for (int r = 0; r < 16; ++r) { float v = acc[r] + RED[(ntile * 16 + r) * 64 + lane] + bias; v = v * sigmoidf_(v); HID[crow(r, hi) * 136 + 32 * ntile + r32] = (bf16_t)f2bf(v); } }
    __syncthreads();
    if (khalf == 0) { const bf16_t* w2 = (const bf16_t*)(ws + WS_PHI2) + (size_t)((layer * 2 + kv) * 128 + 32 * ntile + r32) * 128 + 8 * hi; f32x16 o2 = (f32x16){};
#pragma unroll
        for (int ks = 0; ks < 8; ++ks) { const bf16x8 a = *(const LAS bf16x8*)(HID + r32 * 136 + 16 * ks + 8 * hi), bw = *(const bf16x8*)(w2 + 16 * ks); o2 = __builtin_amdgcn_mfma_f32_32x32x16_bf16(a, bw, o2, 0, 0, 0); }
        bf16_t* dst = (bf16_t*)(ws + (kv ? WS_VCMP : WS_KCMP) + (size_t)layer * 512 * 1024) + (size_t)bg * 128 * 128;
#pragma unroll
        for (int r = 0; r < 16; ++r) { const int c = 32 * rg + crow(r, hi); __hip_atomic_store(dst + c * 128 + 32 * ntile + r32, (c < 127) ? (bf16_t)f2bf(o2[r]) : (bf16_t)0, __ATOMIC_RELAXED, __HIP_MEMORY_SCOPE_AGENT); } }
    __syncthreads();
}

template <bool COMB, bool WRX, int OUTM, bool XBF = false>
__device__ __forceinline__ void rms_row(const void* xrow, void* xwr, const float* g, void* orow, const bf16_t* y0, const bf16_t* y1, float w0, float w1, int lane, void* orow8 = nullptr) {
    float v[4][8]; float s = 0.f;
#pragma unroll
    for (int j = 0; j < 4; ++j) { const int e0 = 512 * j + 8 * lane;
        if (XBF) { const u32x4 xx = *(const u32x4*)((const bf16_t*)xrow + e0);
#pragma unroll
            for (int k = 0; k < 4; ++k) { v[j][2 * k] = bf2f(xx[k] & 0xffff); v[j][2 * k + 1] = bf2f(xx[k] >> 16); } }
        else { const f32x4 a = *(const f32x4*)((const float*)xrow + e0), b = *(const f32x4*)((const float*)xrow + e0 + 4);
#pragma unroll
            for (int k = 0; k < 4; ++k) { v[j][k] = a[k]; v[j][4 + k] = b[k]; } }
        if (COMB) { const u32x4 a = *(const u32x4*)(y0 + e0), b = *(const u32x4*)(y1 + e0);
#pragma unroll
            for (int k = 0; k < 4; ++k) { v[j][2 * k] += w0 * bf2f(a[k] & 0xffff) + w1 * bf2f(b[k] & 0xffff); v[j][2 * k + 1] += w0 * bf2f(a[k] >> 16) + w1 * bf2f(b[k] >> 16); } }
        if (WRX) { u32x4 wx;
#pragma unroll
            for (int k = 0; k < 4; ++k) wx[k] = pk2(v[j][2 * k], v[j][2 * k + 1]);
            *(u32x4*)((bf16_t*)xwr + e0) = wx; }
#pragma unroll
        for (int k = 0; k < 8; k += 2) s += v[j][k] * v[j][k] + v[j][k + 1] * v[j][k + 1]; }
    const float rs = rsqrtf(wave_sum(s) * (1.f / DM) + EPS);
#pragma unroll
    for (int j = 0; j < 4; ++j) { const int e0 = 512 * j + 8 * lane; const f32x4 g0 = *(const f32x4*)(g + e0), g1 = *(const f32x4*)(g + e0 + 4);
        float o[8];
#pragma unroll
        for (int k = 0; k < 4; ++k) { o[k] = v[j][k] * rs * g0[k]; o[4 + k] = v[j][4 + k] * rs * g1[k]; }
        if (OUTM == 1) { __builtin_nontemporal_store((f32x4){o[0], o[1], o[2], o[3]}, (f32x4*)((float*)orow + e0)); __builtin_nontemporal_store((f32x4){o[4], o[5], o[6], o[7]}, (f32x4*)((float*)orow + e0 + 4)); }
        else {
            if (OUTM >= 2) { u32x2 w8; w8.x = pk4_fp8(o[0] * SA8, o[1] * SA8, o[2] * SA8, o[3] * SA8); w8.y = pk4_fp8(o[4] * SA8, o[5] * SA8, o[6] * SA8, o[7] * SA8); *(u32x2*)((unsigned char*)orow8 + e0) = w8; }
            if (OUTM == 2) continue;
            u32x4 w;
#pragma unroll
            for (int k = 0; k < 4; ++k) w[k] = pk2(o[2 * k], o[2 * k + 1]);
            *(u32x4*)((bf16_t*)orow + e0) = w; }
    }
}
__device__ __forceinline__ void rms_row_bf16(const float* xrow, const float* g, bf16_t* orow, int lane) { rms_row<false, false, 0>(xrow, nullptr, g, orow, nullptr, nullptr, 0.f, 0.f, lane); }
__device__ __forceinline__ void moe_row_src(unsigned char* ws, const volatile LAS int* tab, int r, const bf16_t*& y0, const bf16_t*& y1, float& w0, float& w1) {
    const int* rt = (const int*)(ws + WS_WT) + (size_t)r * 4; const float* rw = (const float*)(ws + WS_WT + 512 * 1024) + (size_t)r * 2;
    const int e0 = __builtin_amdgcn_readfirstlane(rt[0]), r0 = __builtin_amdgcn_readfirstlane(rt[1]), e1 = __builtin_amdgcn_readfirstlane(rt[2]), r1 = __builtin_amdgcn_readfirstlane(rt[3]);
    const int s0 = __builtin_amdgcn_readfirstlane(tab[e0]) * 256 + r0, s1 = __builtin_amdgcn_readfirstlane(tab[e1]) * 256 + r1;
    y0 = (const bf16_t*)(ws + WS_Y) + (size_t)s0 * DM; y1 = (const bf16_t*)(ws + WS_Y) + (size_t)s1 * DM; w0 = rw[0]; w1 = rw[1];
}
struct TrDesc { const float* sp; bf16_t* dp; unsigned lds_, ldd; int nvalid; float f8s; const float* rs; int kp; };
__device__ __forceinline__ TrDesc tr_desc(const float* src, size_t lds_, int k0, int sc0, int nvalid, bf16_t* dst, size_t ldd, size_t drow0, int dk0) {
    TrDesc d; d.sp = src + (size_t)k0 * lds_ + sc0; d.dp = dst + drow0 * ldd + dk0; d.lds_ = (unsigned)lds_; d.ldd = (unsigned)ldd; d.nvalid = nvalid; d.f8s = 0.f; d.rs = nullptr; d.kp = -1; return d;
}
__device__ __forceinline__ void tr_load(const TrDesc& d, f32x4 (&v)[8], float (&gs)[8], int lane) {
    const int r = lane >> 3, c4 = (lane & 7) * 4; const float* sp = d.sp + (size_t)r * d.lds_ + c4;
#pragma unroll
    for (int i = 0; i < 8; ++i) gs[i] = d.rs ? d.rs[8 * i + r] : 1.f;
#pragma unroll
    for (int i = 0; i < 8; ++i) v[i] = (c4 < d.nvalid) ? __builtin_nontemporal_load((const f32x4*)(sp + (size_t)(8 * i) * d.lds_)) : (f32x4){0.f, 0.f, 0.f, 0.f};
}
__device__ __forceinline__ void tr_store(const TrDesc& d, const f32x4 (&v)[8], const float (&gs)[8], LAS float* scr, int lane) {
    const int r = lane >> 3, c4 = (lane & 7) * 4;
#pragma unroll
    for (int i = 0; i < 8; ++i) { LAS float* w = scr + (8 * i + r) * 33 + c4; w[0] = v[i][0] * gs[i]; w[1] = v[i][1] * gs[i]; w[2] = v[i][2] * gs[i]; w[3] = v[i][3] * gs[i]; }
    asm volatile("s_waitcnt lgkmcnt(0)" ::: "memory");
    const int c = lane & 7;
#pragma unroll
    for (int j = 0; j < 4; ++j) { const int n = (lane >> 3) + 8 * j; const LAS float* s = scr + (8 * c) * 33 + n;
        if (d.f8s != 0.f) { const float q = d.f8s; u32x2 o8; int koff = 8 * c;
            if (d.kp >= 0) { const int k = d.kp + 8 * c, kk = k & 255; koff = (k & ~255) + ((kk >> 5) & 3) * 64 + ((kk >> 3) & 3) * 16 + (kk >> 7) * 8 - d.kp; }     o8.x = pk4_fp8(s[0 * 33] * q, s[1 * 33] * q, s[2 * 33] * q, s[3 * 33] * q); o8.y = pk4_fp8(s[4 * 33] * q, s[5 * 33] * q, s[6 * 33] * q, s[7 * 33] * q);
            __builtin_nontemporal_store(o8, (u32x2*)((unsigned char*)d.dp + (size_t)n * d.ldd + koff)); }
        else { u32x4 o; o.x = pk2(s[0 * 33], s[1 * 33]); o.y = pk2(s[2 * 33], s[3 * 33]); o.z = pk2(s[4 * 33], s[5 * 33]); o.w = pk2(s[6 * 33], s[7 * 33]);
            __builtin_nontemporal_store(o, (u32x4*)(d.dp + (size_t)n * d.ldd + 8 * c)); } }
    asm volatile("s_waitcnt lgkmcnt(0)" ::: "memory");
}
__device__ __forceinline__ int inproj_src(int vn0, int& nvalid) {
    const int t = vn0 >> 8, r = vn0 & 255, bj = r >> 7, qd = r & 127; nvalid = 32;
    int base; bool d128;
    if (t < 2) { base = t * 256; d128 = false; }
    else if (t == 2) { base = 512; d128 = false; }
    else if (t < 7) { base = 768 + (t - 3) * 256; d128 = true; }
    else if (t < 13) { base = 1792 + (t - 7) * 256; d128 = true; }
    else if (t < 15) { base = 3352 + (t - 13) * 256; d128 = false; }
    else if (t < 17) { base = 3864 + (t - 15) * 256; d128 = false; }
    else if (t < 19) { base = 4376 + (t - 17) * 256; d128 = true; }
    else if (t == 19) { if (r == 0) { nvalid = 24; return 3328; } nvalid = 0; return 0; }
    else return 4888 + (t - 20) * 256 + r;
    if (d128) { const int hh = qd >> 6, i = qd & 63; return base + hh * 128 + bj * 64 + i; }
    const int hh = qd >> 5, i = qd & 31; return base + hh * 64 + bj * 32 + i;
}

struct Args { const void* in[35]; float* out; unsigned char* ws; int ph_lo, ph_hi; };

__device__ __forceinline__ TrDesc desc_small(const __attribute__((address_space(4))) Args* a, int l, int it) {
    unsigned char* ws = a->ws;
    if (it < 32 * 352) { const int kb = it / 352, ng = it % 352; int nv; const int sc = inproj_src(ng * 32, nv);
        bool f8; const int lt = local_of_tile(ng >> 3, f8), lrow = lt * 256 + (ng & 7) * 32;
        TrDesc d = tr_desc((const float*)a->in[4] + (size_t)l * DM * INW, INW, kb * 64, sc, nv, (bf16_t*)(ws + WS_WIN) + (size_t)l * NV16 * DM, DM, lrow, kb * 64);
        if (f8) { d.dp = (bf16_t*)(ws + WS_WIN8 + (size_t)l * NV8 * DM + (size_t)lrow * DM + kb * 64); d.f8s = SW8; }
        return d; } it -= 32 * 352;
    if (it < 8 * 64) { const int kb = it / 64, ng = it % 64; return tr_desc((const float*)a->in[17] + (size_t)l * 512 * DM, DM, kb * 64, ng * 32, 32, (bf16_t*)(ws + WS_WPCAT) + (size_t)l * DM * DM, DM, ng * 32, kb * 64); } it -= 8 * 64;
    if (it < 16 * 64) { const int kb = it / 64, ng = it % 64; return tr_desc((const float*)a->in[18] + (size_t)l * 1024 * DM, DM, kb * 64, ng * 32, 32, (bf16_t*)(ws + WS_WPCAT) + (size_t)l * DM * DM, DM, ng * 32, 512 + kb * 64); } it -= 16 * 64;
    if (it < 8 * 64) { const int kb = it / 64, ng = it % 64; return tr_desc((const float*)a->in[19] + (size_t)l * 512 * DM, DM, kb * 64, ng * 32, 32, (bf16_t*)(ws + WS_WPCAT) + (size_t)l * DM * DM, DM, ng * 32, 1536 + kb * 64); } it -= 8 * 64;
    if (it < 32 * 64) { const int kb = it / 64, ng = it % 64; TrDesc d = tr_desc((const float*)a->in[20] + (size_t)l * DM * DM, DM, kb * 64, ng * 32, 32, (bf16_t*)(ws + WS_WOUT) + (size_t)l * DM * DM, DM, ng * 32, kb * 64);
        if (F_F8) { d.dp = (bf16_t*)(ws + WS_WOUT + (size_t)l * DM * DM + (size_t)(ng * 32) * DM + kb * 64); d.f8s = SW8; d.kp = kb * 64; }
        return d; } it -= 32 * 64;
    if (it < 32 * 16) { const int kb = it / 16, ng = it % 16; TrDesc d = tr_desc((const float*)a->in[23] + (size_t)l * DM * 512, 512, kb * 64, ng * 32, 32, (bf16_t*)(ws + WS_WXCAT) + (size_t)l * 1536 * DM, DM, ng * 32, kb * 64);
        d.rs = (const float*)a->in[21] + (size_t)l * DM + kb * 64; return d; } it -= 32 * 16;
    if (it < 32 * 32) { const int kb = it / 32, ng = it % 32; return tr_desc((const float*)a->in[24] + (size_t)l * DM * 1024, 1024, kb * 64, ng * 32, 32, (bf16_t*)(ws + WS_WXCAT) + (size_t)l * 1536 * DM, DM, 512 + ng * 32, kb * 64); } it -= 32 * 32;
    if (it < 8 * 64) { const int kb = it / 64, ng = it % 64; return tr_desc((const float*)a->in[25] + (size_t)l * 512 * DM, DM, kb * 64, ng * 32, 32, (bf16_t*)(ws + WS_WXO) + (size_t)l * DM * 512, 512, ng * 32, kb * 64); } it -= 8 * 64;
    if (it < 2 * 64 * 4) { const int kv = it / 256, r = it % 256, kb = r / 4, ng = r % 4; return tr_desc((const float*)a->in[kv ? 10 : 8] + (size_t)l * 4096 * 128, 128, kb * 64, ng * 32, 32, (bf16_t*)(ws + WS_PHI1) + (size_t)(l * 2 + kv) * 128 * 4096, 4096, ng * 32, kb * 64); } it -= 512;
    { const int kv = it / 8, r = it % 8, kb = r / 4, ng = r % 4; return tr_desc((const float*)a->in[kv ? 11 : 9] + (size_t)l * 128 * 128, 128, kb * 64, ng * 32, 32, (bf16_t*)(ws + WS_PHI2) + (size_t)(l * 2 + kv) * 128 * 128, 128, ng * 32, kb * 64); }
}
constexpr int N_SMALL_ITEMS = 32 * 352 + 512 + 1024 + 512 + 2048 + 512 + 1024 + 512 + 512 + 16;
constexpr int N_MOE_ITEMS = NEXP * (32 * 64 + 16 * 64);
__device__ __forceinline__ TrDesc desc_moe(const __attribute__((address_space(4))) Args* a, int l, int it) {
    unsigned char* ws = a->ws; const int e = it / 3072; int r = it % 3072;
    if (r < 2048) { const int kb = r / 64, ng = r % 64, vn0 = ng * 32, pnl = vn0 >> 8, bj = (vn0 >> 7) & 1, c = vn0 & 127;
        TrDesc d = tr_desc((const float*)a->in[bj ? 32 : 31] + ((size_t)l * NEXP + e) * DM * DFF, DFF, kb * 64, pnl * 128 + c, 32, (bf16_t*)(ws + WS_WGU) + (size_t)e * DM * DM, DM, vn0, kb * 64);
        if (MOE_F8(l)) { d.dp = (bf16_t*)(ws + WS_WGU + (size_t)l * 64 * MiB + (size_t)e * DM * DM + (size_t)vn0 * DM + kb * 64); d.f8s = SW8; }
        d.rs = (const float*)a->in[26] + (size_t)l * DM + kb * 64; return d; }
    r -= 2048; { const int kb = r / 64, ng = r % 64; TrDesc d = tr_desc((const float*)a->in[33] + ((size_t)l * NEXP + e) * DFF * DM, DM, kb * 64, ng * 32, 32, (bf16_t*)(ws + WS_WD) + (size_t)e * DM * DFF, DFF, ng * 32, kb * 64);
        if (MOE_F8(l)) { d.dp = (bf16_t*)(ws + WS_WD + (size_t)l * 32 * MiB + (size_t)e * DM * DFF + (size_t)(ng * 32) * DFF + kb * 64); d.f8s = SW8; }
        return d; }
}
constexpr int H_CLAIM = 144, M_CLAIM = 72, N_CLAIM = 40;
#ifndef CONV_IN_ATTN
#define CONV_IN_ATTN 0
#endif
constexpr int CONV_CH = 392;
__host__ __device__ constexpr int conv_space(int l) { return N_MOE_ITEMS + (l == 0 && DEPTH > 1 ? N_SMALL_ITEMS : 0); }
__host__ __device__ constexpr int conv_chunks(int l) { return (conv_space(l) + CONV_CH - 1) / CONV_CH; }
__device__ __forceinline__ TrDesc conv_desc(const __attribute__((address_space(4))) Args* a, int mode, int l, int it) {
    if (mode == 0) return desc_small(a, l, it);
    if (it < N_MOE_ITEMS) return desc_moe(a, l, it);
    return desc_small(a, 1, it - N_MOE_ITEMS);
}
__device__ __forceinline__ void convert_run(const __attribute__((address_space(4))) Args* a, int mode, int l, int it0, int end, int stride, LAS float* scr, int lane) {
    if (it0 >= end) return;
    const int n = (end - it0 + stride - 1) / stride;
    f32x4 v0[8], v1[8], v2[8], v3[8]; float g_v0[8], g_v1[8], g_v2[8], g_v3[8];
#define CV_LOAD(V, j) do { const TrDesc d_ = conv_desc(a, mode, l, it0 + (j) * stride); tr_load(d_, V, g_##V, lane); } while (0)
#define CV_STORE(V, j) do { const TrDesc d_ = conv_desc(a, mode, l, it0 + (j) * stride); tr_store(d_, V, g_##V, scr, lane); } while (0)
    CV_LOAD(v0, 0);
    if (n > 1) CV_LOAD(v1, 1);
    if (n > 2) CV_LOAD(v2, 2);
    for (int j = 0; j < n; j += 4) {
        if (j + 3 < n) CV_LOAD(v3, j + 3);
        CV_STORE(v0, j);
        if (j + 1 >= n) break;
        if (j + 4 < n) CV_LOAD(v0, j + 4);
        CV_STORE(v1, j + 1);
        if (j + 2 >= n) break;
        if (j + 5 < n) CV_LOAD(v1, j + 5);
        CV_STORE(v2, j + 2);
        if (j + 3 >= n) break;
        if (j + 6 < n) CV_LOAD(v2, j + 6);
        CV_STORE(v3, j + 3);
    }
#undef CV_LOAD
#undef CV_STORE
}

__device__ __forceinline__ void idle_convert(const __attribute__((address_space(4))) Args* a, unsigned* head, int n, volatile LAS unsigned* misc, LAS float* scr, int tid, int wid, int lane) {
    if (tid == 0) misc[2] = __hip_atomic_fetch_add(head, (unsigned)n, __ATOMIC_RELAXED, __HIP_MEMORY_SCOPE_AGENT);
    __syncthreads();
    const int base = __builtin_amdgcn_readfirstlane((int)misc[2]);
    __syncthreads();
    const int total = conv_space(1); if (base >= total) return;
    const int end = base + n < total ? base + n : total;
    convert_run(a, 1, 1, base + wid, end, 8, scr, lane);
}

#define XB_TMO      128
#define XB_XCNT(j)  (256  + 64 * (j))
#define XB_XSUB(j)  (1280 + 64 * (j))
#define XB_XGEN(j)  (2304 + 64 * (j))
#define XB_TOP      3328
#define XB_TOPGEN   3392
#define XCD_BAR_WORDS 3456
#define XB_SPIN_CAP (1u << 22)
__device__ __forceinline__ unsigned xb_ld(unsigned* p)              { return __hip_atomic_load(p, __ATOMIC_RELAXED, __HIP_MEMORY_SCOPE_AGENT); }
__device__ __forceinline__ unsigned xb_add(unsigned* p, unsigned v) { return __hip_atomic_fetch_add(p, v, __ATOMIC_RELAXED, __HIP_MEMORY_SCOPE_AGENT); }
__device__ __forceinline__ unsigned xb_xcc_id() { return (unsigned)__builtin_amdgcn_s_getreg((3 << 11) | 20) & 0xFu; }
#define XB_SPIN(cond, bar) do { unsigned _sp = 0; while (cond) { __builtin_amdgcn_s_sleep(1); \
    if ((++_sp & 255u) == 0u) { if (xb_ld(&(bar)[XB_TMO])) break; if (_sp > XB_SPIN_CAP) { atomicAdd(&(bar)[XB_TMO], 1u); break; } } } } while (0)
struct XcdBarrier { unsigned* bar; unsigned x; volatile LAS unsigned* st; int wid; };
__device__ __forceinline__ XcdBarrier xcd_barrier_post(unsigned* bar, volatile LAS unsigned* st) {
    XcdBarrier b; b.bar = bar; b.x = xb_xcc_id(); b.st = st; b.wid = 0;
    if (threadIdx.x == 0) (void)xb_add(&bar[XB_XCNT(b.x)], 1u);
    return b;
}
__device__ __forceinline__ void xcd_barrier_complete(unsigned* bar, unsigned x, unsigned& nloc, unsigned& nx) {
    const unsigned G = gridDim.x * gridDim.y * gridDim.z;
    unsigned sum, cnt, mine, sp = 0u;
    for (;;) {
        sum = 0u; cnt = 0u; mine = 0u;
#pragma unroll 1
        for (unsigned j = 0; j < 16; ++j) { const unsigned c = xb_ld(&bar[XB_XCNT(j)]); sum += c; cnt += (c > 0u) ? 1u : 0u; mine = (j == x) ? c : mine; }
        if (sum == G) break;
        __builtin_amdgcn_s_sleep(1);
        if ((++sp & 255u) == 0u) { if (xb_ld(&bar[XB_TMO])) break; if (sp > XB_SPIN_CAP) { atomicAdd(&bar[XB_TMO], 1u); break; } }
    }
    nloc = mine > 0u ? mine : 1u; nx = cnt > 0u ? cnt : 1u;
}
__device__ __forceinline__ void xcd_barrier(const XcdBarrier& b) {
    asm volatile("s_waitcnt vmcnt(0)" ::: "memory");
    __syncthreads();
    if (b.wid == 0 && hw_lane() == 0) {
        unsigned* bar = b.bar;
        __builtin_amdgcn_s_waitcnt(0);
        unsigned nloc = b.st[0], nx = b.st[1];
        if (nloc == 0u) { xcd_barrier_complete(bar, b.x, nloc, nx); b.st[0] = nloc; b.st[1] = nx; }
        const unsigned old = xb_add(&bar[XB_XSUB(b.x)], 1u);
        const unsigned gen = old / nloc;
        if (old + 1u == (gen + 1u) * nloc) {
            __builtin_amdgcn_fence(__ATOMIC_RELEASE, "agent");
            asm volatile("s_waitcnt vmcnt(0)" ::: "memory");
            const unsigned og = xb_add(&bar[XB_TOP], 1u);
            const unsigned tg = og / nx;
            if (og + 1u == (tg + 1u) * nx) xb_add(&bar[XB_TOPGEN], 1u);
            else XB_SPIN(xb_ld(&bar[XB_TOPGEN]) == tg, bar);
            __builtin_amdgcn_fence(__ATOMIC_ACQUIRE, "agent");
            xb_add(&bar[XB_XGEN(b.x)], 1u);
            asm volatile("s_waitcnt vmcnt(0)" ::: "memory");
        } else {
            XB_SPIN(xb_ld(&bar[XB_XGEN(b.x)]) == gen, bar);
            __builtin_amdgcn_fence(__ATOMIC_ACQUIRE, "agent");
            asm volatile("s_waitcnt vmcnt(0)" ::: "memory");
        }
    }
    __syncthreads();
}

constexpr int PH_PER_LAYER = 13, N_PHASES = 1 + DEPTH * PH_PER_LAYER + 1;
typedef const __attribute__((address_space(4))) Args* ArgsP;
__device__ __forceinline__ bool in_range(ArgsP p, int k) { asm volatile("" : "+s"(p)); return p->ph_lo <= k && k < p->ph_hi; }
__global__ void __launch_bounds__(512, 2) mega_fwd(Args args_unused) {
    extern __shared__ __attribute__((aligned(16))) unsigned char lds_raw[];
    LAS unsigned char* lds = (LAS unsigned char*)lds_raw;
    volatile LAS unsigned* MISC = (volatile LAS unsigned*)(lds + MISC_OFF);
    volatile LAS int* MOETAB = (volatile LAS int*)(lds + RING_BYTES + 512);
    const ArgsP ap0 = (ArgsP)__builtin_amdgcn_kernarg_segment_ptr();
    const int tid0 = threadIdx.x; const int wid0 = __builtin_amdgcn_readfirstlane(tid0 >> 6);
    const int G = gridDim.x, bx0 = blockIdx.x, NGW = G * 8;
    if (tid0 < 256) ((LAS unsigned*)(lds + RING_BYTES))[tid0] = 0u;
    __syncthreads();
    const int lo = ap0->ph_lo, hi = ap0->ph_hi;
    const bool use_bar = (hi - lo) > 1;
    XcdBarrier bar; bar.bar = (unsigned*)(ap0->ws + WS_CTL) + CW_BAR; bar.x = 0; bar.st = nullptr; bar.wid = wid0;
    if (use_bar) { bar = xcd_barrier_post((unsigned*)(ap0->ws + WS_CTL) + CW_BAR, MISC + 8); bar.wid = wid0; }
#ifndef PHASE_MASK
#define PHASE_MASK 0xFFFF
#endif
#ifndef ITEM_MASK
#define ITEM_MASK 7
#endif
#define ITEM_ON(i) (((ITEM_MASK) >> (i)) & 1)
#define PHON(i) (((PHASE_MASK) >> (i)) & 1)
#ifndef REP_MASK
#define REP_MASK 0
#endif
#ifndef REP_CNT
#define REP_CNT 2
#endif
#define NREP(i) ((((REP_MASK) >> (i)) & 1) ? REP_CNT : 1)
#define IN(k) in_range(ap0, (k))
#define SEAM(k) do { if (IN(k) && IN((k) + 1)) xcd_barrier(bar); } while (0)
#define PHASE_VIEW() ArgsP ap = ap0; asm volatile("" : "+s"(ap)); unsigned char* ws = ap->ws; unsigned* ctl = (unsigned*)(ws + WS_CTL); \
    int bx = bx0; asm volatile("" : "+s"(bx)); int tid = wid0 * 64 + hw_lane(); asm volatile("" : "+v"(tid)); int wid_ = wid0; asm volatile("" : "+s"(wid_)); const int lane = tid & 63, wid = wid_, gw = bx * 8 + wid; LAS float* scr = (LAS float*)(lds + wid * 16384); \
    (void)ctl; (void)lane; (void)gw; (void)scr
#define INP(k) ((const float*)ap->in[k])
    for (int rep = 0; rep < NREP(0); ++rep) if (PHON(0) && IN(0)) { if (rep) xcd_barrier(bar); PHASE_VIEW();
        convert_run(ap, 0, 0, gw, N_SMALL_ITEMS, NGW, scr, lane);
        if (!CONV_IN_ATTN) convert_run(ap, 1, 0, gw, conv_space(0), NGW, scr, lane);
        { const int* pos = (const int*)ap->in[2]; f32x2* r128 = (f32x2*)(ws + WS_ROPE128); f32x2* r64 = (f32x2*)(ws + WS_ROPE64);
          const int i = tid & 63; const float inv = (float)pow(10000.0, -(double)(2 * i) / 128.0);
          for (int idx = bx * 512 + tid; idx < NTOK * 64; idx += G * 512) { const int tk = idx >> 6; const float ang = (float)pos[tk] * inv;
              const f32x2 cs = {cosf(ang), sinf(ang)}; r128[idx] = cs; if ((i & 1) == 0) r64[tk * 32 + (i >> 1)] = cs; } }
        { bf16_t* wr16 = (bf16_t*)(ws + WS_WRT + 512 * 1024);
          for (int idx = bx * 512 + tid; idx < DEPTH * 32 * DM; idx += G * 512) { const int l = idx / (32 * DM), r = idx % (32 * DM), n = r / DM, k = r % DM;
              const float v = (n < 4) ? INP(27)[((size_t)l * DM + k) * 4 + n] : (n < 20 ? INP(29)[((size_t)l * DM + k) * 16 + (n - 4)] : 0.f); wr16[idx] = (bf16_t)f2bf(v * INP(26)[(size_t)l * DM + k]); }
          float* cb = (float*)(ws + WS_CBIAS);
          for (int w = gw; w < DEPTH * 2 * 128 * 4; w += NGW) { const int o = w >> 2, q = w & 3, l = o >> 8, kv = (o >> 7) & 1, n = o & 127; const float* pe = INP(kv ? 7 : 6) + (size_t)l * 4096; const float* w1 = INP(kv ? 10 : 8) + (size_t)l * 4096 * 128;
              float s = 0.f; for (int k = q * 1024 + lane; k < (q + 1) * 1024; k += 64) s += pe[k] * w1[(size_t)k * 128 + n]; s = wave_sum(s); if (lane == 0) cb[w] = s; } }
        for (int r = gw; r < NTOK; r += NGW) rms_row<false, true, 3>(INP(0) + (size_t)r * DM, (bf16_t*)(ws + WS_X) + (size_t)r * DM, INP(3), (bf16_t*)(ws + WS_HA) + (size_t)r * DM, nullptr, nullptr, 0.f, 0.f, lane, (unsigned char*)(ws + WS_OCAT) + (size_t)r * DM);
    }
    SEAM(0);

    for (int l = 0; l < DEPTH; ++l) {
        const int pb = 1 + l * PH_PER_LAYER;
        for (int rep = 0; rep < NREP(1); ++rep) if (PHON(1) && IN(pb + 0) && l > 0) { if (rep) xcd_barrier(bar); PHASE_VIEW();
            if (wid == 0) pg8::moe_table(MOETAB, ctl + CW_CNT + (l - 1) * 16 * 64, lane);
            __syncthreads();
            for (int r = gw; r < NTOK; r += NGW) { const bf16_t *y0, *y1; float w0, w1; moe_row_src(ws, MOETAB, r, y0, y1, w0, w1);
                rms_row<true, true, 3, true>((const bf16_t*)(ws + WS_X) + (size_t)r * DM, (bf16_t*)(ws + WS_X) + (size_t)r * DM, INP(3) + (size_t)l * DM, (bf16_t*)(ws + WS_HA) + (size_t)r * DM, y0, y1, w0, w1, lane, (unsigned char*)(ws + WS_OCAT) + (size_t)r * DM); }
            if (!CONV_IN_ATTN) { __syncthreads(); int c0 = MOE_F8(1) ? (int)ctl[CW_CH] : 0; c0 = c0 < conv_space(l) ? c0 : conv_space(l); convert_run(ap, 1, l, c0 + gw, conv_space(l), NGW, scr, lane); }
        }
        if (l > 0) SEAM(pb + 0);
        for (int rep = 0; rep < NREP(2); ++rep) if (PHON(2) && IN(pb + 1)) { if (rep) xcd_barrier(bar); PHASE_VIEW();
            { pg8::Gemm g{(const bf16_t*)(ws + WS_HA), (const bf16_t*)(ws + WS_WIN) + (size_t)l * NV16 * DM, DM, wid};
              pg8::StaticOrder S; S.init(NTOK, NV16, G, bx, DM);
              EpiInProj E{ws, 1.f, 0, 0, 0};
              pg8::gemm_phase<EpiInProj, pg8::StaticOrder, true, false>(lds, g, S, E); }
            { pg8::Gemm g{(const bf16_t*)(ws + WS_OCAT), (const bf16_t*)(ws + WS_WIN8 + (size_t)l * NV8 * DM), DM, wid};
              pg8::StaticOrder S; S.init(NTOK, NV8, G, bx, DM / 2);
              EpiInProj E{ws, 1.f / (SA8 * SW8), 1, 0, 0};
              pg8::gemm_phase<EpiInProj, pg8::StaticOrder, true, true>(lds, g, S, E); }
        }
        SEAM(pb + 1);
        for (int rep = 0; rep < NREP(4); ++rep) if (PHON(4) && IN(pb + 3)) { if (rep) xcd_barrier(bar); PHASE_VIEW();
            float lam, lambda_init;
            { const float* lq1 = INP(12) + l * 64; const float* lk1 = INP(13) + l * 64; const float* lq2 = INP(14) + l * 64; const float* lk2 = INP(15) + l * 64;
              const float s1 = wave_sum(lq1[lane] * lk1[lane]), s2 = wave_sum(lq2[lane] * lk2[lane]); lambda_init = 0.8f - 0.6f * expf(-0.3f * (float)l); lam = expf(s1) - expf(s2) + lambda_init; }
            for (int r = gw; r < NB * NMEM; r += NGW) rms_row_bf16(INP(1) + (size_t)r * DM, INP(22) + (size_t)l * DM, (bf16_t*)(ws + WS_HM) + (size_t)r * DM, lane);
            unsigned* qh = ctl + CW_Q + l * 64 + rep * 4; unsigned* cdone = ctl + CW_CD + l * 64;
            bool cseen = false;
            for (;;) {
                if (tid == 0) MISC[0] = atomicAdd(qh, 1u);
                __syncthreads();
                const int it = __builtin_amdgcn_readfirstlane((int)MISC[0]);
                __syncthreads();
                const int nch = CONV_IN_ATTN ? conv_chunks(l) : 0;
                if (it >= 128 + 1536 + nch) break;
                int tid_o = tid; asm volatile("" : "+v"(tid_o));
                const int lane = tid_o & 63, wid = __builtin_amdgcn_readfirstlane(tid_o >> 6);
                if (it < 128) {
                    compress_item(lds, ws, l, it >> 6, (it >> 2) & 15, it & 3, wid, lane);
                    asm volatile("s_waitcnt vmcnt(0)" ::: "memory"); __syncthreads();
                    if (tid == 0) __hip_atomic_fetch_add(cdone, 1u, __ATOMIC_RELAXED, __HIP_MEMORY_SCOPE_AGENT);
                    continue;
                }
                const int itq = it - 128;
                const int pq = itq / 9;
                if (itq % 9 == 8 && pq < nch) {
                    const int c0 = pq * CONV_CH, c1 = (c0 + CONV_CH < conv_space(l)) ? c0 + CONV_CH : conv_space(l);
                    convert_run(ap, 1, l, c0 + wid, c1, 8, (LAS float*)(lds + wid * 16384), lane);
                    __syncthreads();
                    continue;
                }
                const int ita = itq - (pq < nch ? pq : nch);
                if (ITEM_ON(0) && ita >= 512 && ita < 1024) { const int i = ita - 512, qb = 31 - (i >> 4), bg = i & 15;
                    if (!cseen) {
                        if (tid == 0) { unsigned sp = 0; while (__hip_atomic_load(cdone, __ATOMIC_RELAXED, __HIP_MEMORY_SCOPE_AGENT) < 128u * (unsigned)(rep + 1)) { __builtin_amdgcn_s_sleep(2); if (++sp > (1u << 22)) break; } }
                        __syncthreads(); __builtin_amdgcn_fence(__ATOMIC_ACQUIRE, "agent"); asm volatile("s_waitcnt vmcnt(0)" ::: "memory"); __syncthreads(); cseen = true; }
                    attn_item_nsa(lds, ws, l, bg >> 1, bg & 1, qb, wid, lane); }
                else if (ITEM_ON(1) && ita < 512) { const int i = ita, qb = 15 - (i >> 5), bh = i & 31; attn_item_diff(lds, ws, INP(16) + l * 128, lam, lambda_init, bh >> 2, bh & 3, qb, wid, lane); }
                else if (ITEM_ON(2) && ita >= 1024) { const int i = ita - 1024, qb = 31 - (i >> 4), bk = i & 15; attn_item_swa(lds, ws, INP(5) + l * 8, bk >> 1, bk & 1, qb, wid, lane); }
            }
        }
        SEAM(pb + 3);
        for (int rep = 0; rep < NREP(5); ++rep) if (PHON(5) && IN(pb + 4)) { if (rep) xcd_barrier(bar); PHASE_VIEW();
            pg8::Gemm g{(const bf16_t*)(ws + WS_OCAT), (const bf16_t*)(ws + WS_WPCAT) + (size_t)l * DM * DM, DM, wid};
            pg8::StaticOrder S; S.init(NTOK, DM, G, bx, DM);
            EpiMerge E{(const unsigned char*)(ws + WS_MG), (bf16_t*)(ws + WS_QKV), 8, 24};
            pg8::gemm_phase<EpiMerge, pg8::StaticOrder, true>(lds, g, S, E);
        }
        SEAM(pb + 4);
        for (int rep = 0; rep < NREP(6); ++rep) if (PHON(6) && IN(pb + 5)) { if (rep) xcd_barrier(bar); PHASE_VIEW();
            pg8::Gemm g{(const bf16_t*)(ws + WS_QKV), (const bf16_t*)(ws + WS_WOUT + (F_F8 ? (size_t)l * DM * DM : (size_t)l * DM * DM * 2)), DM, wid};
            pg8::StaticOrder S; S.init(NTOK, DM, G, bx, F_F8 ? DM / 2 : DM);
            EpiResidual E{(bf16_t*)(ws + WS_X), nullptr, (float*)(ws + WS_SSQ), F_F8 ? 1.f / (SM8 * SW8) : 1.f, 0, 0};
            pg8::gemm_phase<EpiResidual, pg8::StaticOrder, true, F_F8 != 0>(lds, g, S, E);
        }
        SEAM(pb + 5);
        for (int rep = 0; rep < NREP(8); ++rep) if (PHON(8) && IN(pb + 7)) { if (rep) xcd_barrier(bar); PHASE_VIEW();
            pg8::Gemm g{(const bf16_t*)(ws + WS_X), (const bf16_t*)(ws + WS_WXCAT) + (size_t)l * 1536 * DM, DM, wid};
            if (MOE_F8(1) && l == 0 && bx >= 160) idle_convert(ap, ctl + CW_CH, H_CLAIM, MISC, scr, tid, wid, lane);
            pg8::XqOrder S{bx};
            LAS float* rstdl = (LAS float*)(lds + RING_BYTES + 1024);
            if (bx < 128) { const int row = (bx >> 1) * 256 + (tid >> 1); const f32x4* p4 = (const f32x4*)((const float*)(ws + WS_SSQ) + (size_t)row * 32 + (tid & 1) * 16);
                const f32x4 a0 = p4[0], a1 = p4[1], a2 = p4[2], a3 = p4[3]; float sm = ((a0[0] + a0[1]) + (a0[2] + a0[3])) + ((a1[0] + a1[1]) + (a1[2] + a1[3])) + ((a2[0] + a2[1]) + (a2[2] + a2[3])) + ((a3[0] + a3[1]) + (a3[2] + a3[3]));
                sm += __shfl_xor(sm, 1); if ((tid & 1) == 0) rstdl[tid >> 1] = rsqrtf(sm * (1.f / DM) + EPS); }
            __syncthreads();
            EpiXq E{(bf16_t*)(ws + WS_QX), (bf16_t*)(ws + WS_KVM), rstdl, 0, 0};
            pg8::gemm_phase<EpiXq, pg8::XqOrder, false>(lds, g, S, E);
        }
        SEAM(pb + 7);
        for (int rep = 0; rep < NREP(9); ++rep) if (PHON(9) && IN(pb + 8)) { if (rep) xcd_barrier(bar); PHASE_VIEW();
            for (int it = bx; it < 256; it += G) attn_item_cross(lds, ws, it >> 5, (it >> 3) & 3, it & 7, wid, lane);
        }
        SEAM(pb + 8);
        for (int rep = 0; rep < NREP(10); ++rep) if (PHON(10) && IN(pb + 9)) { if (rep) xcd_barrier(bar); PHASE_VIEW();
            pg8::Gemm g{(const bf16_t*)(ws + WS_OX), (const bf16_t*)(ws + WS_WXO) + (size_t)l * DM * 512, 512, wid};
            pg8::StaticOrder S; S.init(NTOK, DM, G, bx, 512);
            EpiResidual E{(bf16_t*)(ws + WS_X), (unsigned char*)(ws + WS_OCAT), (float*)(ws + WS_SSQ) + (size_t)NTOK * 32, 1.f, 0, 0};
            pg8::gemm_phase<EpiResidual, pg8::StaticOrder, true>(lds, g, S, E);
        }
        SEAM(pb + 9);
        for (int rep = 0; rep < NREP(11); ++rep) if (PHON(11) && IN(pb + 10)) { if (rep) xcd_barrier(bar); PHASE_VIEW();
            const float* bgp = INP(28) + l * 4; const float* bep = INP(30) + l * 16;
            const bf16_t* wr16 = (const bf16_t*)(ws + WS_WRT + 512 * 1024) + (size_t)l * 32 * DM;
            int* tokt = (int*)(ws + WS_TOK); unsigned* cntw = ctl + CW_CNT + l * 16 * 64;
            const int r32 = lane & 31, hi = lane >> 5;
            LAS float* P = (LAS float*)lds;
            LAS float* L = (LAS float*)(lds + 32768);
            LAS float* RSL = (LAS float*)(lds + 32768 + 16384);
            for (int rb = bx * 64; rb < NTOK; rb += G * 64) {
                { const int row = tid >> 3; const f32x4 pv_ = *((const f32x4*)((const float*)(ws + WS_SSQ) + (size_t)NTOK * 32 + (size_t)(rb + row) * 32) + (tid & 7));
                  float sm = (pv_[0] + pv_[1]) + (pv_[2] + pv_[3]); sm += __shfl_xor(sm, 1); sm += __shfl_xor(sm, 2); sm += __shfl_xor(sm, 4);
                  if ((tid & 7) == 0) { const float rs_ = rsqrtf(sm * (1.f / DM) + EPS); RSL[row] = rs_; ((float*)(ws + WS_RSTD))[rb + row] = rs_; } }
                __syncthreads();
                { const int tile = wid & 1, kp = wid >> 1; f32x16 acc = (f32x16){};
                  const bf16_t* ap_ = (const bf16_t*)(ws + WS_X) + (size_t)(rb + 32 * tile + r32) * DM + kp * 512 + 8 * hi; const bf16_t* bp_ = wr16 + (size_t)r32 * DM + kp * 512 + 8 * hi;
#pragma unroll 8
                  for (int ks = 0; ks < 32; ++ks) { const bf16x8 a = *(const bf16x8*)(ap_ + 16 * ks), b = *(const bf16x8*)(bp_ + 16 * ks); acc = __builtin_amdgcn_mfma_f32_32x32x16_bf16(a, b, acc, 0, 0, 0); }
                  LAS float* pp = P + wid * 1024 + lane;
#pragma unroll
                  for (int r = 0; r < 16; ++r) pp[r * 64] = acc[r]; }
                __syncthreads();
                if (wid < 2) {
                    LAS float* pp = P + wid * 1024 + lane; LAS float* lp = L + wid * (32 * 33) + r32;
#pragma unroll
                    for (int r = 0; r < 16; ++r) { const float v = (pp[r * 64] + pp[2048 + r * 64]) + (pp[4096 + r * 64] + pp[6144 + r * 64]); lp[((r & 3) + 8 * (r >> 2) + 4 * hi) * 33] = v; }
                    asm volatile("s_waitcnt lgkmcnt(0)" ::: "memory");
                    if (lane < 32) { const int tk = rb + 32 * wid + lane; const LAS float* lr = L + wid * (32 * 33) + lane * 33; const float rsr = RSL[32 * wid + lane];
                        float gl[4]; int gi = 0;
#pragma unroll
                        for (int n = 0; n < 4; ++n) gl[n] = lr[n] * rsr + bgp[n];
                        float gmx = gl[0];
#pragma unroll
                        for (int n = 1; n < 4; ++n) if (gl[n] > gmx) { gmx = gl[n]; gi = n; }
                        float gs = 0.f;
#pragma unroll
                        for (int n = 0; n < 4; ++n) gs += expf(gl[n] - gmx);
                        const float gp = 1.f / gs;
                        float el[4];
#pragma unroll
                        for (int n = 0; n < 4; ++n) el[n] = lr[4 + 4 * gi + n] * rsr + bep[4 * gi + n];
                        int e0 = 0; float m0 = el[0];
#pragma unroll
                        for (int n = 1; n < 4; ++n) if (el[n] > m0) { m0 = el[n]; e0 = n; }
                        int e1 = -1; float m1 = -INFINITY;
#pragma unroll
                        for (int n = 0; n < 4; ++n) if (n != e0 && el[n] > m1) { m1 = el[n]; e1 = n; }
                        const float p1 = expf(m1 - m0); const float w0 = gp / (1.f + p1), w1 = gp * p1 / (1.f + p1);
                        if (rep == 0) { const int ea = gi * 4 + e0, eb = gi * 4 + e1;
                            const unsigned ra = atomicAdd(cntw + ea * 64, 1u), rbk = atomicAdd(cntw + eb * 64, 1u);
                            tokt[ea * NTOK + ra] = tk; tokt[eb * NTOK + rbk] = tk; ((float*)(ws + WS_RSTDT))[ea * NTOK + ra] = rsr; ((float*)(ws + WS_RSTDT))[eb * NTOK + rbk] = rsr;
                            ((int*)(ws + WS_WT))[tk * 4 + 0] = ea; ((int*)(ws + WS_WT))[tk * 4 + 1] = (int)ra; ((int*)(ws + WS_WT))[tk * 4 + 2] = eb; ((int*)(ws + WS_WT))[tk * 4 + 3] = (int)rbk;
                            ((float*)(ws + WS_WT + 512 * 1024))[tk * 2 + 0] = w0; ((float*)(ws + WS_WT + 512 * 1024))[tk * 2 + 1] = w1; } }
                }
                __syncthreads();
            }
        }
        SEAM(pb + 10);
        for (int rep = 0; rep < NREP(12); ++rep) if (PHON(12) && IN(pb + 11)) { if (rep) xcd_barrier(bar); PHASE_VIEW();
            if (wid == 0) pg8::moe_table(MOETAB, ctl + CW_CNT + l * 16 * 64, lane);
            __syncthreads();
            if (MOE_F8(l)) {
                pg8::Gemm g{(const bf16_t*)(ws + WS_OCAT), (const bf16_t*)(ws + WS_WGU + (size_t)l * 64 * MiB), DM, wid};
                pg8::MoeOrder S; S.init(MOETAB, G, bx, (const int*)(ws + WS_TOK), true, DM / 2);
                EpiMoeUp E{(bf16_t*)(ws + WS_HMOE), 1.f / (SA8 * SW8), 1, (const float*)(ws + WS_RSTDT), (const int*)(ws + WS_TOK), MOETAB, 0, 0};
                pg8::gemm_phase<EpiMoeUp, pg8::MoeOrder, true, true>(lds, g, S, E);
                if (MOE_F8(1) && l == 0) { const int per = (S.U + 7) >> 3, i0 = bx >> 3, nb = G >> 3; const int nu = i0 < per ? (per - i0 + nb - 1) / nb : 0, numax = (per + nb - 1) / nb;
                    if (nu < numax) idle_convert(ap, ctl + CW_CH, M_CLAIM, MISC, scr, tid, wid, lane); }
            } else {
                pg8::Gemm g{(const bf16_t*)(ws + WS_X), (const bf16_t*)(ws + WS_WGU), DM, wid};
                pg8::MoeOrder S; S.init(MOETAB, G, bx, (const int*)(ws + WS_TOK), true, DM);
                EpiMoeUp E{(bf16_t*)(ws + WS_HMOE), 1.f, 0, (const float*)(ws + WS_RSTDT), (const int*)(ws + WS_TOK), MOETAB, 0, 0};
                pg8::gemm_phase<EpiMoeUp, pg8::MoeOrder, true>(lds, g, S, E);
            }
        }
        SEAM(pb + 11);
        for (int rep = 0; rep < NREP(13); ++rep) if (PHON(13) && IN(pb + 12)) { if (rep) xcd_barrier(bar); PHASE_VIEW();
            if (wid == 0) pg8::moe_table(MOETAB, ctl + CW_CNT + l * 16 * 64, lane);
            __syncthreads();
            if (MOE_F8(l)) {
                pg8::Gemm g{(const bf16_t*)(ws + WS_HMOE), (const bf16_t*)(ws + WS_WD + (size_t)l * 32 * MiB), DFF, wid};
                pg8::MoeOrder S; S.init(MOETAB, G, bx, (const int*)(ws + WS_TOK), false, DFF / 2);
                EpiMoeDown E{(bf16_t*)(ws + WS_Y), 1.f / (SH8 * SW8), 0, 0};
                pg8::gemm_phase<EpiMoeDown, pg8::MoeOrder, true, true>(lds, g, S, E);
                if (MOE_F8(1) && l == 0) { const int per = (S.U + 7) >> 3, i0 = bx >> 3, nb = G >> 3; const int nu = i0 < per ? (per - i0 + nb - 1) / nb : 0, numax = (per + nb - 1) / nb;
                    if (nu < numax) idle_convert(ap, ctl + CW_CH, N_CLAIM, MISC, scr, tid, wid, lane); }
            } else {
                pg8::Gemm g{(const bf16_t*)(ws + WS_HMOE), (const bf16_t*)(ws + WS_WD), DFF, wid};
                pg8::MoeOrder S; S.init(MOETAB, G, bx, (const int*)(ws + WS_TOK), false, DFF);
                EpiMoeDown E{(bf16_t*)(ws + WS_Y), 1.f, 0, 0};
                pg8::gemm_phase<EpiMoeDown, pg8::MoeOrder, true>(lds, g, S, E);
            }
        }
        SEAM(pb + 12);
    }
    for (int rep = 0; rep < NREP(14); ++rep) if (PHON(14) && IN(N_PHASES - 1)) { if (rep) xcd_barrier(bar); PHASE_VIEW();
        if (wid == 0) pg8::moe_table(MOETAB, ctl + CW_CNT + (DEPTH - 1) * 16 * 64, lane);
        __syncthreads();
        for (int r = gw; r < NTOK; r += NGW) { const bf16_t *y0, *y1; float w0, w1; moe_row_src(ws, MOETAB, r, y0, y1, w0, w1);
            rms_row<true, false, 1, true>((const bf16_t*)(ws + WS_X) + (size_t)r * DM, nullptr, INP(34), ap->out + (size_t)r * DM, y0, y1, w0, w1, lane); }
    }
#undef IN
#undef SEAM
}

#ifndef MK_SPLIT
#define MK_SPLIT 0
#endif
extern "C" void kernel_launch(void* const* d_in, const int* in_sizes, int n_in, void* d_out, int out_size, void* d_ws, size_t ws_size, hipStream_t stream) {
    static int grid = 0;
    if (grid == 0) {
        if (n_in != 35 || out_size != NTOK * DM || ws_size < WS_END) { fprintf(stderr, "kernel_launch: unexpected problem (n_in %d, out %d, ws %zu < %zu)\n", n_in, out_size, ws_size, (size_t)WS_END); grid = -1; return; }
        int dev = 0, cus = 0, per_cu = 0;
        if (hipGetDevice(&dev) != hipSuccess || hipDeviceGetAttribute(&cus, hipDeviceAttributeMultiprocessorCount, dev) != hipSuccess) { grid = -1; return; }
        if (hipFuncSetAttribute((const void*)mega_fwd, hipFuncAttributeMaxDynamicSharedMemorySize, LDS_BYTES) != hipSuccess) { fprintf(stderr, "kernel_launch: hipFuncSetAttribute failed\n"); grid = -1; return; }
        if (hipOccupancyMaxActiveBlocksPerMultiprocessor(&per_cu, (const void*)mega_fwd, 512, LDS_BYTES) != hipSuccess || per_cu < 1) { fprintf(stderr, "kernel_launch: occupancy query says %d\n", per_cu); }
        (void)hipGetLastError();
        grid = cus;
        if (grid % 8 != 0) grid -= grid % 8;
    }
    if (grid < 0) return;
    (void)hipMemsetAsync((char*)d_ws + WS_CTL, 0, CTL_BYTES, stream);
    Args a{};
    for (int i = 0; i < 35; ++i) a.in[i] = d_in[i];
    a.out = (float*)d_out; a.ws = (unsigned char*)d_ws;
#if MK_SPLIT
    for (int p = 0; p < N_PHASES; ++p) {
        if (p == 1) continue;
        a.ph_lo = p; a.ph_hi = p + 1;
        hipLaunchKernelGGL(mega_fwd, dim3(grid), dim3(512), LDS_BYTES, stream, a);
    }
#else
    a.ph_lo = 0; a.ph_hi = N_PHASES;
    hipLaunchKernelGGL(mega_fwd, dim3(grid), dim3(512), LDS_BYTES, stream, a);
#endif
}
```

```cpp
#include <hip/hip_runtime.h>
#include <cstdint>
#include <cstdio>

#define LAS __attribute__((address_space(3)))
#define GAS __attribute__((address_space(1)))
typedef unsigned short bf16_t;
typedef short bf16x8 __attribute__((ext_vector_type(8)));
typedef short v4i16_t __attribute__((ext_vector_type(4)));
typedef float f32x2 __attribute__((ext_vector_type(2)));
typedef float f32x4 __attribute__((ext_vector_type(4)));
typedef float f32x16 __attribute__((ext_vector_type(16)));
typedef unsigned u32x2 __attribute__((ext_vector_type(2)));
typedef unsigned u32x4 __attribute__((ext_vector_type(4)));
typedef __bf16 bf16x2_t __attribute__((ext_vector_type(2)));

constexpr int DM = 2048, NB = 8, SEQ = 2048, NTOK = NB * SEQ, NMEM = 256, DEPTH = 2;
constexpr int INW = 11032, INV = 11264;
constexpr int NEXP = 16, DFF = 1024;
constexpr float EPS = 1e-6f;
constexpr float LOG2E = 1.4426950408889634f;
constexpr float QSC64 = 0.125f * LOG2E, QSC128 = 0.08838834764831845f * LOG2E;

constexpr size_t MiB = 1u << 20;
constexpr size_t WS_CTL = 0, CTL_BYTES = 1 * MiB;
constexpr size_t WS_WIN = 1 * MiB;
#ifndef INPROJ_BF16_TILES
#define INPROJ_BF16_TILES 4
#endif
#if INPROJ_BF16_TILES == 8
constexpr int NV16 = 2048, NV8 = 9216;
__host__ __device__ constexpr int tile_of_bf16(int pn) { return pn < 2 ? pn : pn + 11; }
__host__ __device__ constexpr int tile_of_fp8(int pn) { return pn < 11 ? pn + 2 : (pn == 11 ? 19 : pn + 8); }
__host__ __device__ constexpr int local_of_tile(int t, bool& f8) { if (t < 2) { f8 = false; return t; } if (t >= 13 && t < 19) { f8 = false; return t - 11; } f8 = true; return t < 13 ? t - 2 : (t == 19 ? 11 : t - 8); }
#else
constexpr int NV16 = 1024, NV8 = 10240;
__host__ __device__ constexpr int tile_of_bf16(int pn) { return pn + 13; }
__host__ __device__ constexpr int tile_of_fp8(int pn) { return pn < 13 ? pn : pn + 4; }
__host__ __device__ constexpr int local_of_tile(int t, bool& f8) { if (t >= 13 && t < 17) { f8 = false; return t - 13; } f8 = true; return t < 13 ? t : t - 4; }
#endif
constexpr size_t WS_WIN8 = WS_WIN + 16 * MiB;
constexpr size_t WS_WPCAT = WS_WIN + 88 * MiB;
constexpr size_t WS_WOUT = WS_WPCAT + 16 * MiB;
constexpr size_t WS_WXCAT = WS_WOUT + 16 * MiB;
constexpr size_t WS_WXO = WS_WXCAT + 12 * MiB;
constexpr size_t WS_PHI1 = WS_WXO + 4 * MiB;
constexpr size_t WS_PHI2 = WS_PHI1 + 4 * MiB;
constexpr size_t WS_WGU = WS_PHI2 + 1 * MiB;
constexpr size_t WS_WD = WS_WGU + 128 * MiB;
constexpr size_t WS_ROPE128 = WS_WD + 64 * MiB;
constexpr size_t WS_ROPE64 = WS_ROPE128 + 8 * MiB;
constexpr size_t WS_WRT = WS_ROPE64 + 4 * MiB;
constexpr size_t WS_CBIAS = WS_WRT + 1 * MiB;
constexpr size_t WS_TOK = WS_CBIAS + 1 * MiB;
constexpr size_t WS_WT = WS_TOK + 1 * MiB;
constexpr size_t WS_X = WS_WT + 1 * MiB;
constexpr size_t WS_RSTDT = WS_X + 64 * MiB;
constexpr size_t WS_HA = WS_X + 128 * MiB;
constexpr size_t WS_HM = WS_HA + 64 * MiB;
constexpr size_t WS_QKV = WS_HM + 8 * MiB;
constexpr size_t WS_QA = WS_QKV, WS_KA = WS_QA + 16 * MiB, WS_VA = WS_KA + 4 * MiB, WS_QB = WS_VA + 4 * MiB;
constexpr size_t WS_KCB = WS_QB + 32 * MiB, WS_VCB = WS_KCB + 9 * MiB, WS_KSB = WS_VCB + 9 * MiB, WS_VSB = WS_KSB + 8 * MiB, WS_KWB = WS_VSB + 8 * MiB, WS_VWB = WS_KWB + 8 * MiB;
constexpr size_t WS_QC = WS_VWB + 8 * MiB, WS_KC = WS_QC + 16 * MiB, WS_VC = WS_KC + 16 * MiB, WS_GATEB = WS_VC + 16 * MiB, WS_KCMP = WS_GATEB + 2 * MiB, WS_VCMP = WS_KCMP + 1 * MiB;
constexpr size_t WS_QKV_END = WS_VCMP + 1 * MiB;
constexpr size_t WS_QX = WS_QKV, WS_KVM = WS_QX + 16 * MiB, WS_OX = WS_KVM + 4 * MiB;
constexpr size_t WS_MG = WS_QKV_END;
constexpr size_t WS_HMOE = WS_MG;
constexpr size_t WS_Y = WS_QKV;
static_assert(WS_Y + (size_t)36864 * 2048 * 2 <= WS_MG, "Y overlay");
constexpr size_t WS_OCAT = WS_MG + 192 * MiB;
constexpr size_t WS_SSQ = WS_OCAT + 64 * MiB;
constexpr size_t WS_RSTD = WS_SSQ + 4 * MiB;
constexpr size_t WS_END = WS_RSTD + 1 * MiB;
static_assert(WS_END <= 1000 * MiB, "workspace map");

constexpr int CW_BAR = 4096;
constexpr int CW_CNT = 16384;
constexpr int CW_Q = 32768;
constexpr int CW_CH = 57344;
constexpr int CW_CD = 49152;

constexpr int RING_BYTES = 131072, MISC_OFF = RING_BYTES + 320, LDS_BYTES = 147456;

#define LOG2E_ 1.4426950408889634f
__device__ __forceinline__ unsigned f2bf(float f) { unsigned u = __builtin_bit_cast(unsigned, f); return (u + 0x7fffu + ((u >> 16) & 1u)) >> 16; }
__device__ __forceinline__ unsigned pk2(float lo, float hi) { f32x2 v = {lo, hi}; bf16x2_t b = __builtin_convertvector(v, bf16x2_t); return __builtin_bit_cast(unsigned, b); }
typedef int v8i32 __attribute__((ext_vector_type(8)));
constexpr float SA8 = 32.f, SW8 = 512.f;
__device__ __forceinline__ unsigned pk4_fp8(float a, float b, float c, float d) {
    a = fminf(fmaxf(a, -448.f), 448.f); b = fminf(fmaxf(b, -448.f), 448.f); c = fminf(fmaxf(c, -448.f), 448.f); d = fminf(fmaxf(d, -448.f), 448.f);
    unsigned w = 0u; w = __builtin_amdgcn_cvt_pk_fp8_f32(a, b, w, false); w = __builtin_amdgcn_cvt_pk_fp8_f32(c, d, w, true); return w; }
__device__ __forceinline__ float bf2f(unsigned short h) { return __builtin_bit_cast(float, (unsigned)h << 16); }
__device__ __forceinline__ float sigmoidf_(float z) { return __builtin_amdgcn_rcpf(1.0f + __builtin_amdgcn_exp2f(-LOG2E_ * z)); }
__device__ __forceinline__ int hw_lane() { return (int)__builtin_amdgcn_mbcnt_hi(~0u, __builtin_amdgcn_mbcnt_lo(~0u, 0u)); }
__device__ __forceinline__ float wave_sum(float v) {
#pragma unroll
    for (int o = 1; o < 64; o <<= 1) v += __shfl_xor(v, o);
    return v;
}

namespace pg8 {
constexpr int BM = 256, BK = 64, HALF = 128, HTB = HALF * BK * 2, STAGE_BYTES = 8 * HTB;
__host__ __device__ __forceinline__ int lds_byte(int r, int c) { const int st = (r >> 4) * 2 + (c >> 5), rr = r & 15, cc = c & 31, ob = rr * 64 + cc * 2; return st * 1024 + (ob ^ (((ob >> 9) & 1) << 5)); }
__host__ __device__ __forceinline__ void stage_rc(int b, int& R, int& C) { const int st = b / 1024, sb = b % 1024, swz = sb ^ (((sb >> 9) & 1) << 5); R = (st >> 1) * 16 + swz / 64; C = (st & 1) * 32 + (swz % 64) / 2; }
__host__ __device__ __forceinline__ int perm32(int rho) { const int n = rho >> 4, i = rho & 15; return 8 * (i >> 2) + 4 * n + (i & 3); }

struct Unit { int pm, pn, e, r; };
struct Gemm { const bf16_t* A; const bf16_t* Bt; int K; int wid; };

template <class Epi, class Sched, bool ALIGN_EPI, bool F8 = false>
__device__ __forceinline__ void gemm_phase(LAS unsigned char* lds, const Gemm g, const Sched& S, const Epi& E) {
    int tid = g.wid * 64 + hw_lane(); asm volatile("" : "+v"(tid));
    const int wid = __builtin_amdgcn_readfirstlane(tid >> 6), lane = tid & 63, wr = wid >> 2, wc = wid & 3, fr = lane & 15, fq = lane >> 4;
    const int KB = F8 ? g.K : g.K * 2, nt = KB / (BK * 2);
    unsigned voffB[2];
#pragma unroll
    for (int i = 0; i < 2; ++i) { int R, C; stage_rc(tid * 16 + i * 8192, R, C); const int Rb = Epi::PERM ? ((R & ~31) + perm32(R & 31)) : R; voffB[i] = (unsigned)(Rb * KB + C * 2); }
    const size_t kstep = (size_t)(BK * 2);
    const size_t hstep = (size_t)HALF * KB;
    const size_t tstep = 2 * hstep;
    const unsigned ldsw = (unsigned)wid * 1024u;
    const int fcol = fq * 8;
    const int aoff = lds_byte(wr * 64 + fr, fcol), boff = lds_byte(wc * 32 + fr, fcol);
    constexpr int KOFF = 1024;
#define PG8_SA(b, h) (((b) * 2 + (h)) * HTB)
#define PG8_SB(b, h) ((4 + (b) * 2 + (h)) * HTB)
#define PG8_STAGE(bufoff, gbase, voff) do { _Pragma("unroll") for (int _i = 0; _i < 2; ++_i) \
        __builtin_amdgcn_global_load_lds((const unsigned*)((const char*)(gbase) + (voff)[_i]), (LAS unsigned*)(lds + (bufoff) + ldsw + _i * 8192), 16, 0, 0); } while (0)
#define PG8_LDA(dst, b, h) do { _Pragma("unroll") for (int m = 0; m < 4; ++m) _Pragma("unroll") for (int k = 0; k < 2; ++k) dst[m][k] = *(const LAS bf16x8*)(lds + PG8_SA(b, h) + aoff + m * 2048 + k * KOFF); } while (0)
#define PG8_LDB(dst, b, h) do { _Pragma("unroll") for (int n = 0; n < 2; ++n) _Pragma("unroll") for (int k = 0; k < 2; ++k) dst[n][k] = *(const LAS bf16x8*)(lds + PG8_SB(b, h) + boff + n * 2048 + k * KOFF); } while (0)
#define PG8_CAT8(x) __builtin_shufflevector(__builtin_bit_cast(u32x4, x[0]), __builtin_bit_cast(u32x4, x[1]), 0, 1, 2, 3, 4, 5, 6, 7)
#define PG8_MMA(ai, bj, At, Bt) do { __builtin_amdgcn_s_setprio(1); _Pragma("unroll") for (int m = 0; m < 4; ++m) _Pragma("unroll") for (int n = 0; n < 2; ++n) { \
        if constexpr (F8) acc[ai][bj][m][n] = __builtin_amdgcn_mfma_scale_f32_16x16x128_f8f6f4(__builtin_bit_cast(v8i32, PG8_CAT8(Bt[n])), __builtin_bit_cast(v8i32, PG8_CAT8(At[m])), acc[ai][bj][m][n], 0, 0, 0, 0x7f7f7f7f, 0, 0x7f7f7f7f); \
        else { _Pragma("unroll") for (int k = 0; k < 2; ++k) acc[ai][bj][m][n] = __builtin_amdgcn_mfma_f32_16x16x32_bf16(Bt[n][k], At[m][k], acc[ai][bj][m][n], 0, 0, 0); } } \
        __builtin_amdgcn_s_setprio(0); } while (0)
#define PG8_WAIT_V(n) asm volatile("s_waitcnt vmcnt(" #n ")" ::: "memory")
#define PG8_WAIT_L(n) asm volatile("s_waitcnt lgkmcnt(" #n ")" ::: "memory")
#define PG8_BAR __builtin_amdgcn_s_barrier()
#define PG8_SCHED __builtin_amdgcn_sched_barrier(0)
#define PG8_ROWOFFS(dst, u) do { _Pragma("unroll") for (int _i = 0; _i < 2; ++_i) { int _R, _C; stage_rc(tid * 16 + _i * 8192, _R, _C); \
        _Pragma("unroll") for (int _h = 0; _h < 2; ++_h) dst[_h][_i] = S.rowoff(u, _h * HALF + _R) + (unsigned)_C * 2u; } } while (0)
    Unit cur, nxt; int ui = 0;
    if (!S.next(0, cur)) return;
    f32x4 acc[2][2][4][2];
#pragma unroll
    for (int a = 0; a < 2; ++a)
#pragma unroll
        for (int b = 0; b < 2; ++b)
#pragma unroll
            for (int m = 0; m < 4; ++m)
#pragma unroll
                for (int n = 0; n < 2; ++n) acc[a][b][m][n] = (f32x4){0.f, 0.f, 0.f, 0.f};
    bf16x8 At[4][2], B0[2][2], B1[2][2];
    unsigned vA[2][2];
    PG8_ROWOFFS(vA, cur);
    const char* gA = (const char*)g.A;
    const char* cB = (const char*)g.Bt + (size_t)cur.pn * tstep;
    PG8_STAGE(PG8_SB(0, 0), cB, voffB); PG8_STAGE(PG8_SB(0, 1), cB + hstep, voffB); PG8_STAGE(PG8_SA(0, 0), gA, vA[0]); PG8_STAGE(PG8_SA(0, 1), gA, vA[1]);
    if (wr == 1) PG8_BAR;
    PG8_WAIT_V(2); PG8_BAR;
    PG8_STAGE(PG8_SB(1, 0), cB + kstep, voffB); PG8_STAGE(PG8_SA(1, 0), gA + kstep, vA[0]); PG8_STAGE(PG8_SB(1, 1), cB + hstep + kstep, voffB);
    PG8_WAIT_V(6); PG8_BAR;
    for (;;) {
        const bool has_next = S.next(ui + 1, nxt);
        const char* nB = has_next ? (const char*)g.Bt + (size_t)nxt.pn * tstep : cB;
        for (int t = 0; t < nt; t += 2) {
            if constexpr (Epi::HAS_MID) { if (t == E.t1 || t == E.t2) E.mid(acc, cur, t, wr, wc, fr, fq); }
            const bool last = (t == nt - 2);
            const char* a1 = gA + (size_t)(t + 1) * kstep;
            const char* a2 = last ? gA : gA + (size_t)(t + 2) * kstep; const char* b2 = last ? nB : cB + (size_t)(t + 2) * kstep;
            const char* a3 = a2 + kstep; const char* b3 = b2 + kstep;
            PG8_LDB(B0, 0, 0); PG8_LDB(B1, 0, 1); PG8_SCHED; PG8_LDA(At, 0, 0); PG8_STAGE(PG8_SA(1, 1), a1, vA[1]);
            if (last && has_next) { PG8_ROWOFFS(vA, nxt); }
            PG8_WAIT_V(8); PG8_WAIT_L(0); PG8_BAR; PG8_MMA(0, 0, At, B0); PG8_MMA(0, 1, At, B1); PG8_BAR; PG8_SCHED;
            PG8_LDA(At, 0, 1); PG8_STAGE(PG8_SB(0, 0), b2, voffB); PG8_STAGE(PG8_SB(0, 1), b2 + hstep, voffB); PG8_STAGE(PG8_SA(0, 0), a2, vA[0]);
            PG8_WAIT_V(8); PG8_WAIT_L(0); PG8_BAR; PG8_MMA(1, 0, At, B0); PG8_MMA(1, 1, At, B1); PG8_BAR; PG8_SCHED;
            PG8_LDB(B0, 1, 0); PG8_LDB(B1, 1, 1); PG8_SCHED; PG8_LDA(At, 1, 0); PG8_STAGE(PG8_SA(0, 1), a2, vA[1]);
            PG8_WAIT_V(8); PG8_WAIT_L(0); PG8_BAR; PG8_MMA(0, 0, At, B0); PG8_MMA(0, 1, At, B1); PG8_BAR; PG8_SCHED;
            PG8_LDA(At, 1, 1); PG8_STAGE(PG8_SB(1, 0), b3, voffB); PG8_STAGE(PG8_SB(1, 1), b3 + hstep, voffB); PG8_STAGE(PG8_SA(1, 0), a3, vA[0]);
            PG8_WAIT_V(8); PG8_WAIT_L(0); PG8_BAR; PG8_MMA(1, 0, At, B0); PG8_MMA(1, 1, At, B1); PG8_BAR; PG8_SCHED;
        }
        if constexpr (ALIGN_EPI) { if (wr == 0) PG8_BAR; }
        E(acc, cur, wr, wc, fr, fq);
#ifdef EPI_TWICE
        if constexpr (Epi::IDEMP) { asm volatile("" ::: "memory"); __builtin_amdgcn_sched_barrier(0); E(acc, cur, wr, wc, fr, fq); }
#endif
        if (!has_next) break;
#pragma unroll
        for (int a = 0; a < 2; ++a)
#pragma unroll
            for (int b = 0; b < 2; ++b)
#pragma unroll
                for (int m = 0; m < 4; ++m)
#pragma unroll
                    for (int n = 0; n < 2; ++n) acc[a][b][m][n] = (f32x4){0.f, 0.f, 0.f, 0.f};
        cur = nxt; cB = nB; ++ui;
        if constexpr (ALIGN_EPI) { if (wr == 1) PG8_BAR; }
    }
    PG8_WAIT_V(0);
    if constexpr (!ALIGN_EPI) { if (wr == 0) PG8_BAR; }
    PG8_BAR;
#undef PG8_SA
#undef PG8_SB
#undef PG8_STAGE
#undef PG8_LDA
#undef PG8_LDB
#undef PG8_MMA
#undef PG8_CAT8
#undef PG8_WAIT_V
#undef PG8_WAIT_L
#undef PG8_BAR
#undef PG8_SCHED
#undef PG8_ROWOFFS
}

struct StaticOrder {
    int nM, nN, nwg, G, c; unsigned ldab;
    __device__ void init(int M, int N, int G_, int c_, int lda_elems) { nM = M / BM; nN = N / BM; nwg = nM * nN; G = G_; c = c_; ldab = (unsigned)lda_elems * 2u; }
    __device__ __forceinline__ bool next(int i, Unit& u) const {
        const long L = (long)i * G + c; if (L >= nwg) return false;
        int wgid = (int)L; { const int q = nwg / 8, r = nwg % 8, xcd = wgid % 8, off = wgid / 8; wgid = (xcd < r ? xcd * (q + 1) : r * (q + 1) + (xcd - r) * q) + off; }
        const int nig = 8 * nN, gid = wgid / nig, fm = gid * 8, gsz = (nM - fm) < 8 ? (nM - fm) : 8;
        u.pm = fm + ((wgid % nig) % gsz); u.pn = (wgid % nig) / gsz; u.e = 0; u.r = 0; return true;
    }
    __device__ __forceinline__ unsigned rowoff(const Unit& u, int row) const { return (unsigned)(u.pm * BM + row) * ldab; }
};
struct XqOrder {
    int c;
    __device__ __forceinline__ bool next(int i, Unit& u) const {
        if (i > 0 || c >= 160) return false;
        if (c < 128) { u.pm = c >> 1; u.pn = c & 1; } else { const int j = c - 128; u.pm = 64 + (j >> 2); u.pn = 2 + (j & 3); }
        u.e = 0; u.r = 0; return true;
    }
    __device__ __forceinline__ unsigned rowoff(const Unit& u, int row) const { return (u.pm < 64 ? 0u : (unsigned)(WS_HM - WS_X) - 64u * BM * (unsigned)(DM * 2)) + (unsigned)(u.pm * BM + row) * (unsigned)(DM * 2); }
};
struct MoeOrder {
    const volatile LAS int* tab;
    int U, G, c; const int* tok; bool gather; unsigned ldab;
    __device__ void init(const volatile LAS int* tab_, int G_, int c_, const int* tok_, bool gather_, int lda_elems) {
        tab = tab_; U = __builtin_amdgcn_readfirstlane(tab_[NEXP]) * 8; G = G_; c = c_; tok = tok_; gather = gather_; ldab = (unsigned)lda_elems * 2u;
    }
    __device__ __forceinline__ bool next(int i, Unit& u) const {
        const int per = (U + 7) >> 3;
        const int xcd = c & 7, idx = (c >> 3) + i * (G >> 3);
        if (idx >= per) return false;
        const int id = xcd * per + idx; if (id >= U) return false;
        const int rt = id >> 3, pnl = id & 7; int e = 0;
        const volatile LAS int* tab = this->tab; asm volatile("" : "+v"(tab));
#pragma unroll
        for (int k = 1; k < NEXP; ++k) e += (rt >= __builtin_amdgcn_readfirstlane(tab[k])) ? 1 : 0;
        e = __builtin_amdgcn_readfirstlane(e);
        u.pm = rt; u.pn = e * 8 + pnl; u.e = e; u.r = rt - __builtin_amdgcn_readfirstlane(tab[e]); return true;
    }
    __device__ __forceinline__ unsigned rowoff(const Unit& u, int row) const {
        if (!gather) return (unsigned)(u.pm * BM + row) * ldab;
        const int slot = u.r * BM + row; int t = 0; if (slot < __builtin_amdgcn_readfirstlane(tab[NEXP + 1 + u.e])) t = tok[u.e * NTOK + slot];
        return (unsigned)t * ldab;
    }
};
__device__ __forceinline__ void moe_table(volatile LAS int* tab, const unsigned* cntw, int lane) {
    int n = 0; if (lane < NEXP) { n = (int)cntw[lane * 64]; n = n < 0 ? 0 : (n > NTOK ? NTOK : n); }
    const int t = (n + 255) >> 8; int incl = t;
#pragma unroll
    for (int d = 1; d < NEXP; d <<= 1) { const int v = __shfl_up(incl, d); if (lane >= d) incl += v; }
    if (lane < NEXP) { tab[NEXP + 1 + lane] = n; tab[lane] = incl - t; }
    if (lane == NEXP - 1) tab[NEXP] = incl;
}
}

struct TileInfo { unsigned long long off; int ld, cb; float sc; int flags; };
__constant__ TileInfo TILE_INFO[20] = {
    {WS_QA, 512, 0, QSC64, 2}, {WS_QA, 512, 256, QSC64, 2}, {WS_KA, 128, 0, 1.f, 2},
    {WS_QB, 1024, 0, QSC128, 3}, {WS_QB, 1024, 256, QSC128, 3}, {WS_QB, 1024, 512, QSC128, 3}, {WS_QB, 1024, 768, QSC128, 3},
    {WS_KCB, 128, 0, 1.f, 7}, {WS_VCB, 128, 0, 1.f, 5}, {WS_KSB, 256, 0, 1.f, 3}, {WS_VSB, 256, 0, 1.f, 1}, {WS_KWB, 256, 0, 1.f, 3}, {WS_VWB, 256, 0, 1.f, 1},
    {WS_QC, 512, 0, QSC64, 2}, {WS_QC, 512, 256, QSC64, 2}, {WS_KC, 512, 0, 1.f, 2}, {WS_KC, 512, 256, 1.f, 2}, {WS_VC, 512, 0, 1.f, 1}, {WS_VC, 512, 256, 1.f, 1},
    {WS_VA, 128, -128, 1.f, 0} };
#define PIN16(x) asm volatile("" : "+v"(x[0][0]), "+v"(x[0][1]), "+v"(x[0][2]), "+v"(x[0][3]), "+v"(x[1][0]), "+v"(x[1][1]), "+v"(x[1][2]), "+v"(x[1][3]), \
                                   "+v"(x[2][0]), "+v"(x[2][1]), "+v"(x[2][2]), "+v"(x[2][3]), "+v"(x[3][0]), "+v"(x[3][1]), "+v"(x[3][2]), "+v"(x[3][3]))
struct EpiInProj {
    static constexpr bool IDEMP = true, PERM = true, HAS_MID = false;
    unsigned char* ws; float asc; int f8call; int t1, t2;
    __device__ __forceinline__ void operator()(const f32x4 (&acc_)[2][2][4][2], const pg8::Unit& u, int wr, int wc, int fr, int fq) const {
        f32x4 acc[2][2][4][2];
#pragma unroll
        for (int a_ = 0; a_ < 2; ++a_)
#pragma unroll
            for (int b_ = 0; b_ < 2; ++b_)
#pragma unroll
                for (int m_ = 0; m_ < 4; ++m_)
#pragma unroll
                    for (int n_ = 0; n_ < 2; ++n_) acc[a_][b_][m_][n_] = acc_[a_][b_][m_][n_] * asc;
        const int t = f8call ? tile_of_fp8(u.pn) : tile_of_bf16(u.pn); const int row0 = u.pm * 256 + wr * 64 + fr;
        if (t >= 20) {
            unsigned char* MG = ws + WS_MG; const int col0 = (t - 20) * 256 + wc * 64 + 16 * fq;
#pragma unroll
            for (int ai = 0; ai < 2; ++ai)
#pragma unroll
                for (int m = 0; m < 4; ++m) { unsigned char* rp = MG + (size_t)(row0 + ai * 128 + m * 16) * 6144 + col0; u32x4 w4;
#pragma unroll
                    for (int bj = 0; bj < 2; ++bj) { const f32x4 v0 = acc[ai][bj][m][0], v1 = acc[ai][bj][m][1]; u32x2 w; w.x = 0u; w.y = 0u;
#pragma unroll
                        for (int e = 0; e < 4; ++e) { w.x = __builtin_amdgcn_cvt_pk_u8_f32(fmaxf(__builtin_rintf(255.f * sigmoidf_(v0[e])), 1.f), e, w.x); w.y = __builtin_amdgcn_cvt_pk_u8_f32(fmaxf(__builtin_rintf(255.f * sigmoidf_(v1[e])), 1.f), e, w.y); }
                        if (bj == 0) { w4.x = w.x; w4.y = w.y; } else { w4.z = w.x; w4.w = w.y; } }
                    *(u32x4*)rp = w4; }
            return;
        }
        if (t == 19) {
            if (wc == 0) { float* GB = (float*)(ws + WS_GATEB);
#pragma unroll
                for (int ai = 0; ai < 2; ++ai)
#pragma unroll
                    for (int m = 0; m < 4; ++m) { float* rp = GB + (size_t)(row0 + ai * 128 + m * 16) * 32 + 8 * fq;
                        const f32x4 v0 = acc[ai][0][m][0], v1 = acc[ai][0][m][1];
                        *(f32x4*)rp = (f32x4){sigmoidf_(v0[0]), sigmoidf_(v0[1]), sigmoidf_(v0[2]), sigmoidf_(v0[3])};
                        *(f32x4*)(rp + 4) = (f32x4){sigmoidf_(v1[0]), sigmoidf_(v1[1]), sigmoidf_(v1[2]), sigmoidf_(v1[3])}; } }
            return;
        }
        bool d128, rope; bf16_t* dst; int ld, cb; float sc = 1.f; bool headmajor = false;
        if (t < 2)       { d128 = false; rope = true;  dst = (bf16_t*)(ws + WS_QA); ld = 512; cb = t * 256; sc = QSC64; }
        else if (t == 2) { d128 = false; rope = wc < 2; if (wc < 2) { dst = (bf16_t*)(ws + WS_KA); ld = 128; cb = 0; } else { dst = (bf16_t*)(ws + WS_VA); ld = 128; cb = -128; } }
        else if (t < 7)  { d128 = true;  rope = true;  dst = (bf16_t*)(ws + WS_QB); ld = 1024; cb = (t - 3) * 256; sc = QSC128; }
        else if (t == 7) { d128 = true;  rope = true;  dst = (bf16_t*)(ws + WS_KCB); ld = 128; cb = 0; headmajor = true; }
        else if (t == 8) { d128 = true;  rope = false; dst = (bf16_t*)(ws + WS_VCB); ld = 128; cb = 0; headmajor = true; }
        else if (t == 9) { d128 = true;  rope = true;  dst = (bf16_t*)(ws + WS_KSB); ld = 256; cb = 0; }
        else if (t == 10){ d128 = true;  rope = false; dst = (bf16_t*)(ws + WS_VSB); ld = 256; cb = 0; }
        else if (t == 11){ d128 = true;  rope = true;  dst = (bf16_t*)(ws + WS_KWB); ld = 256; cb = 0; }
        else if (t == 12){ d128 = true;  rope = false; dst = (bf16_t*)(ws + WS_VWB); ld = 256; cb = 0; }
        else if (t < 15) { d128 = false; rope = true;  dst = (bf16_t*)(ws + WS_QC); ld = 512; cb = (t - 13) * 256; sc = QSC64; }
        else if (t < 17) { d128 = false; rope = true;  dst = (bf16_t*)(ws + WS_KC); ld = 512; cb = (t - 15) * 256; }
        else             { d128 = true;  rope = false; dst = (bf16_t*)(ws + WS_VC); ld = 512; cb = (t - 17) * 256; }
        const int hw = d128 ? 128 : 64, hh = d128 ? (wc >> 1) : wc, i0 = (d128 ? 32 * (wc & 1) : 0) + 8 * fq;
        const f32x2* rt = d128 ? (const f32x2*)(ws + WS_ROPE128) : (const f32x2*)(ws + WS_ROPE64); const int rld = d128 ? 64 : 32;
#pragma unroll
        for (int ai = 0; ai < 2; ++ai)
#pragma unroll
            for (int m = 0; m < 4; ++m) {
                const int row = row0 + ai * 128 + m * 16;
                float x1[8], x2[8];
#pragma unroll
                for (int n = 0; n < 2; ++n)
#pragma unroll
                    for (int e = 0; e < 4; ++e) { x1[4 * n + e] = acc[ai][0][m][n][e]; x2[4 * n + e] = acc[ai][1][m][n][e]; }
                if (rope) {
                    const f32x4* rp = (const f32x4*)(rt + (size_t)row * rld + i0);
#pragma unroll
                    for (int k = 0; k < 4; ++k) { const f32x4 cs = rp[k];
                        { const float a = x1[2 * k], b = x2[2 * k]; x1[2 * k] = a * cs[0] - b * cs[1]; x2[2 * k] = b * cs[0] + a * cs[1]; }
                        { const float a = x1[2 * k + 1], b = x2[2 * k + 1]; x1[2 * k + 1] = a * cs[2] - b * cs[3]; x2[2 * k + 1] = b * cs[2] + a * cs[3]; } }
                }
                u32x4 w1, w2;
                w1.x = pk2(x1[0] * sc, x1[1] * sc); w1.y = pk2(x1[2] * sc, x1[3] * sc); w1.z = pk2(x1[4] * sc, x1[5] * sc); w1.w = pk2(x1[6] * sc, x1[7] * sc);
                w2.x = pk2(x2[0] * sc, x2[1] * sc); w2.y = pk2(x2[2] * sc, x2[3] * sc); w2.z = pk2(x2[4] * sc, x2[5] * sc); w2.w = pk2(x2[6] * sc, x2[7] * sc);
                size_t o;
                if (headmajor) { const int b = row >> 11, s = row & 2047; o = ((size_t)((b * 2 + hh) * 2048 + s)) * 128 + i0; }
                else o = (size_t)row * ld + cb + hh * hw + i0;
                *(u32x4*)(dst + o) = w1; *(u32x4*)(dst + o + hw / 2) = w2;
                asm volatile("" ::: "memory");
            }
    }
};

#ifndef F_F8
#define F_F8 1
#endif
constexpr float SM8 = 16.f;
struct EpiMerge {
    static constexpr bool IDEMP = false, PERM = true, HAS_MID = true;
    const unsigned char* MG; bf16_t* out; int t1, t2;
    static __device__ __forceinline__ void unpack8(float (&f)[8], const u32x2 a) {
        f[0] = (float)(a.x & 0xff); f[1] = (float)((a.x >> 8) & 0xff); f[2] = (float)((a.x >> 16) & 0xff); f[3] = (float)(a.x >> 24); f[4] = (float)(a.y & 0xff); f[5] = (float)((a.y >> 8) & 0xff); f[6] = (float)((a.y >> 16) & 0xff); f[7] = (float)(a.y >> 24); }
    __device__ __forceinline__ void mid(f32x4 (&acc)[2][2][4][2], const pg8::Unit& u, int t, int wr, int wc, int fr_, int fq) const {
        int fr = fr_; asm volatile("" : "+v"(fr));
        const int seg = (t == t1) ? 0 : 1; const int row0 = u.pm * 256 + wr * 64 + fr, col0 = u.pn * 256 + wc * 64 + 16 * fq;
        const unsigned off0 = (unsigned)row0 * 6144u + (unsigned)col0 + (unsigned)seg * 2048u;
        u32x4 g[2][4][2];
#pragma unroll
        for (int ai = 0; ai < 2; ++ai)
#pragma unroll
            for (int m = 0; m < 4; ++m) { const unsigned char* rp = MG + (off0 + (unsigned)(ai * 128 + m * 16) * 6144u); g[ai][m][0] = *(const u32x4*)rp; g[ai][m][1] = *(const u32x4*)(rp + 2048); }
        asm volatile("" : "+v"(g[0][0][0]), "+v"(g[0][0][1]), "+v"(g[0][1][0]), "+v"(g[0][1][1]), "+v"(g[0][2][0]), "+v"(g[0][2][1]), "+v"(g[0][3][0]), "+v"(g[0][3][1]),
                          "+v"(g[1][0][0]), "+v"(g[1][0][1]), "+v"(g[1][1][0]), "+v"(g[1][1][1]), "+v"(g[1][2][0]), "+v"(g[1][2][1]), "+v"(g[1][3][0]), "+v"(g[1][3][1]));
#pragma unroll
        for (int ai = 0; ai < 2; ++ai) {
#pragma unroll
            for (int m = 0; m < 4; ++m)
#pragma unroll
                for (int bj = 0; bj < 2; ++bj) { float f[8], d[8]; unpack8(f, bj ? (u32x2){g[ai][m][0].z, g[ai][m][0].w} : (u32x2){g[ai][m][0].x, g[ai][m][0].y}); unpack8(d, bj ? (u32x2){g[ai][m][1].z, g[ai][m][1].w} : (u32x2){g[ai][m][1].x, g[ai][m][1].y});
#pragma unroll
                    for (int k = 0; k < 8; ++k) f[k] = f[k] * __builtin_amdgcn_rcpf(d[k]);
                    f32x4& v0 = acc[ai][bj][m][0]; f32x4& v1 = acc[ai][bj][m][1];
                    v0[0] *= f[0]; v0[1] *= f[1]; v0[2] *= f[2]; v0[3] *= f[3]; v1[0] *= f[4]; v1[1] *= f[5]; v1[2] *= f[6]; v1[3] *= f[7]; }
        }
    }
    __device__ __forceinline__ void operator()(f32x4 (&acc)[2][2][4][2], const pg8::Unit& u, int wr, int wc, int fr_, int fq_) const {
        int fr = fr_, fq = fq_; asm volatile("" : "+v"(fr), "+v"(fq));
        const int row0 = u.pm * 256 + wr * 64 + fr, col0 = u.pn * 256 + wc * 32 + 8 * fq, gcol = u.pn * 256 + wc * 64 + 16 * fq;
        u32x4 g[4][2];
#pragma unroll
        for (int ai = 0; ai < 2; ++ai)
#pragma unroll
            for (int m = 0; m < 4; ++m) g[m][ai] = *(const u32x4*)(MG + (size_t)(row0 + ai * 128 + m * 16) * 6144 + gcol + 4096);
        asm volatile("" : "+v"(g[0][0]), "+v"(g[0][1]), "+v"(g[1][0]), "+v"(g[1][1]), "+v"(g[2][0]), "+v"(g[2][1]), "+v"(g[3][0]), "+v"(g[3][1]));
#pragma unroll
        for (int ai = 0; ai < 2; ++ai)
#pragma unroll
            for (int m = 0; m < 4; ++m) { bf16_t* op = out + (size_t)(row0 + ai * 128 + m * 16) * DM + col0; u32x4 w84;
#pragma unroll
                for (int bj = 0; bj < 2; ++bj) { float f[8]; unpack8(f, bj ? (u32x2){g[m][ai].z, g[m][ai].w} : (u32x2){g[m][ai].x, g[m][ai].y}); const f32x4 v0 = acc[ai][bj][m][0] * (1.f / 255.f), v1 = acc[ai][bj][m][1] * (1.f / 255.f);
                    if (F_F8) { u32x2 w8; w8.x = pk4_fp8(v0[0] * f[0] * SM8, v0[1] * f[1] * SM8, v0[2] * f[2] * SM8, v0[3] * f[3] * SM8); w8.y = pk4_fp8(v1[0] * f[4] * SM8, v1[1] * f[5] * SM8, v1[2] * f[6] * SM8, v1[3] * f[7] * SM8);
                        if (bj == 0) { w84.x = w8.x; w84.y = w8.y; } else { w84.z = w8.x; w84.w = w8.y; } }
                    else { u32x4 w; w.x = pk2(v0[0] * f[0], v0[1] * f[1]); w.y = pk2(v0[2] * f[2], v0[3] * f[3]); w.z = pk2(v1[0] * f[4], v1[1] * f[5]); w.w = pk2(v1[2] * f[6], v1[3] * f[7]); *(u32x4*)(op + bj * 128) = w; } }
                if (F_F8) *(u32x4*)((unsigned char*)out + (size_t)(row0 + ai * 128 + m * 16) * DM + gcol) = w84; }
    }
};

struct EpiResidual {
    static constexpr bool IDEMP = false, PERM = true, HAS_MID = false;
    bf16_t* xb; unsigned char* xt8; float* ssq; float asc; int t1, t2;
    __device__ __forceinline__ void operator()(const f32x4 (&acc)[2][2][4][2], const pg8::Unit& u, int wr, int wc, int fr_, int fq_) const {
        int fr = fr_, fq = fq_; asm volatile("" : "+v"(fr), "+v"(fq));
        const int col0 = u.pn * 256 + wc * 32 + 8 * fq;
#pragma unroll
        for (int ai = 0; ai < 2; ++ai) {
            u32x4 b[4][2];
#pragma unroll
            for (int m = 0; m < 4; ++m) {
                if (m == 0) {
#pragma unroll
                    for (int mm = 0; mm < 4; ++mm) { const size_t off = (size_t)(u.pm * 256 + ai * 128 + wr * 64 + mm * 16 + fr) * DM + col0;
#pragma unroll
                        for (int bj = 0; bj < 2; ++bj) b[mm][bj] = *(const u32x4*)(xb + off + bj * 128); }
                    asm volatile("" : "+v"(b[0][0]), "+v"(b[0][1]), "+v"(b[1][0]), "+v"(b[1][1]), "+v"(b[2][0]), "+v"(b[2][1]), "+v"(b[3][0]), "+v"(b[3][1]));
                }
                const int row = u.pm * 256 + ai * 128 + wr * 64 + m * 16 + fr; const size_t off = (size_t)row * DM + col0; float ss = 0.f; u32x4 w84;
#pragma unroll
                for (int bj = 0; bj < 2; ++bj) { const u32x4 bb = b[m][bj];
                    const f32x4 v0 = (f32x4){bf2f(bb.x & 0xffff), bf2f(bb.x >> 16), bf2f(bb.y & 0xffff), bf2f(bb.y >> 16)} + acc[ai][bj][m][0] * asc, v1 = (f32x4){bf2f(bb.z & 0xffff), bf2f(bb.z >> 16), bf2f(bb.w & 0xffff), bf2f(bb.w >> 16)} + acc[ai][bj][m][1] * asc;
                    u32x4 w; w.x = pk2(v0[0], v0[1]); w.y = pk2(v0[2], v0[3]); w.z = pk2(v1[0], v1[1]); w.w = pk2(v1[2], v1[3]); *(u32x4*)(xb + off + bj * 128) = w;
                    ss += ((v0[0] * v0[0] + v0[1] * v0[1]) + (v0[2] * v0[2] + v0[3] * v0[3])) + ((v1[0] * v1[0] + v1[1] * v1[1]) + (v1[2] * v1[2] + v1[3] * v1[3]));
                    if (xt8) { u32x2 w8; w8.x = pk4_fp8(v0[0] * SA8, v0[1] * SA8, v0[2] * SA8, v0[3] * SA8); w8.y = pk4_fp8(v1[0] * SA8, v1[1] * SA8, v1[2] * SA8, v1[3] * SA8); if (bj == 0) { w84.x = w8.x; w84.y = w8.y; } else { w84.z = w8.x; w84.w = w8.y; } } }
                if (xt8) { *(u32x2*)(xt8 + off) = (u32x2){w84.x, w84.y}; *(u32x2*)(xt8 + off + 128) = (u32x2){w84.z, w84.w}; }
                ss += __shfl_xor(ss, 16); ss += __shfl_xor(ss, 32); if (fq == 0) ssq[(size_t)row * 32 + u.pn * 4 + wc] = ss;
            }
        }
    }
};

struct EpiXq {
    static constexpr bool IDEMP = false, PERM = true, HAS_MID = false;
    bf16_t* QX; bf16_t* KVM; const LAS float* rstdl; int t1, t2;
    __device__ __forceinline__ void operator()(const f32x4 (&acc)[2][2][4][2], const pg8::Unit& u, int wr, int wc, int fr_, int fq_) const {
        int fr = fr_, fq = fq_; asm volatile("" : "+v"(fr), "+v"(fq));
        bf16_t* base; int ld; float sc; int rowb, colb; int pnv = u.pn; asm volatile("" : "+s"(pnv));
        if (pnv < 2) { base = QX; ld = 512; sc = QSC128; rowb = u.pm * 256; colb = u.pn * 256; } else { base = KVM; ld = 1024; sc = 1.f; rowb = (u.pm - 64) * 256; colb = (u.pn - 2) * 256; }
        asm volatile("" : "+v"(sc));
#pragma unroll
        for (int ai = 0; ai < 2; ++ai)
#pragma unroll
            for (int m = 0; m < 4; ++m) { bf16_t* rp = base + (size_t)(rowb + ai * 128 + wr * 64 + m * 16 + fr) * ld + colb + wc * 32 + 8 * fq; const float scr_ = (pnv < 2) ? sc * rstdl[ai * 128 + wr * 64 + m * 16 + fr] : sc;
#pragma unroll
                for (int bj = 0; bj < 2; ++bj) { const f32x4 v0 = acc[ai][bj][m][0] * scr_, v1 = acc[ai][bj][m][1] * scr_; u32x4 w; w.x = pk2(v0[0], v0[1]); w.y = pk2(v0[2], v0[3]); w.z = pk2(v1[0], v1[1]); w.w = pk2(v1[2], v1[3]);
                    *(u32x4*)(rp + bj * 128) = w; }
                asm volatile("" ::: "memory"); }
    }
};

#ifndef MOE_F8_FROM
#define MOE_F8_FROM 0
#endif
#define MOE_F8(l) ((l) >= MOE_F8_FROM)
constexpr float SH8 = 16.f;
struct EpiMoeUp {
    static constexpr bool IDEMP = false, PERM = true, HAS_MID = false;
    bf16_t* H; float asc; int f8; const float* rstd; const int* tok; const volatile LAS int* tab; int t1, t2;
    __device__ __forceinline__ void operator()(const f32x4 (&acc)[2][2][4][2], const pg8::Unit& u, int wr, int wc, int fr_, int fq_) const {
        int fr = fr_, fq = fq_; asm volatile("" : "+v"(fr), "+v"(fq));
        const int pnl = u.pn & 7, n_e = __builtin_amdgcn_readfirstlane(tab[NEXP + 1 + u.e]);
        float rs[2][4];
#pragma unroll
        for (int ai = 0; ai < 2; ++ai)
#pragma unroll
            for (int m = 0; m < 4; ++m) { const int slot = u.r * 256 + ai * 128 + wr * 64 + m * 16 + fr; rs[ai][m] = (slot < n_e) ? rstd[u.e * NTOK + slot] * asc : 0.f; }
#pragma unroll
        for (int ai = 0; ai < 2; ++ai)
#pragma unroll
            for (int m = 0; m < 4; ++m) { const size_t eo = (size_t)(u.pm * 256 + ai * 128 + wr * 64 + m * 16 + fr) * DFF + pnl * 128 + wc * 32 + 8 * fq; float h[8];
#pragma unroll
                for (int n = 0; n < 2; ++n)
#pragma unroll
                    for (int e = 0; e < 4; ++e) { const float gv = acc[ai][0][m][n][e] * rs[ai][m], uv = acc[ai][1][m][n][e] * rs[ai][m]; h[4 * n + e] = gv * sigmoidf_(gv) * uv; }
                if (f8) { u32x2 w8; w8.x = pk4_fp8(h[0] * SH8, h[1] * SH8, h[2] * SH8, h[3] * SH8); w8.y = pk4_fp8(h[4] * SH8, h[5] * SH8, h[6] * SH8, h[7] * SH8); *(u32x2*)((unsigned char*)H + eo) = w8; }
                else { u32x4 w; w.x = pk2(h[0], h[1]); w.y = pk2(h[2], h[3]); w.z = pk2(h[4], h[5]); w.w = pk2(h[6], h[7]); *(u32x4*)(H + eo) = w; }
                asm volatile("" ::: "memory"); }
    }
};

struct EpiMoeDown {
    static constexpr bool IDEMP = false, PERM = true, HAS_MID = false;
    bf16_t* Y; float asc; int t1, t2;
    __device__ __forceinline__ void operator()(const f32x4 (&acc)[2][2][4][2], const pg8::Unit& u, int wr, int wc, int fr_, int fq_) const {
        int fr = fr_, fq = fq_; asm volatile("" : "+v"(fr), "+v"(fq));
        const int pnl = u.pn & 7;
#pragma unroll
        for (int ai = 0; ai < 2; ++ai)
#pragma unroll
            for (int m = 0; m < 4; ++m) { bf16_t* rp = Y + (size_t)(u.pm * 256 + ai * 128 + wr * 64 + m * 16 + fr) * DM + pnl * 256 + wc * 32 + 8 * fq;
#pragma unroll
                for (int bj = 0; bj < 2; ++bj) { const f32x4 v0 = acc[ai][bj][m][0] * asc, v1 = acc[ai][bj][m][1] * asc; u32x4 w; w.x = pk2(v0[0], v0[1]); w.y = pk2(v0[2], v0[3]); w.z = pk2(v1[0], v1[1]); w.w = pk2(v1[2], v1[3]);
                    *(u32x4*)(rp + bj * 128) = w; }
                asm volatile("" ::: "memory"); }
    }
};

#ifndef QK_SB
#define QK_SB 0
#endif
#ifndef PV_SB
#define PV_SB 0
#endif
constexpr int ATT_STAGE = 32768;
constexpr int ATT_X = 65536;

template <int DQK> __device__ __forceinline__ void dma_k(LAS unsigned char* dst, const bf16_t* src, int ld, int wid, int lane) {
    constexpr int NC = DQK / 8;
    const bf16_t* rowp = src + (size_t)lane * ld;
#pragma unroll
    for (int ii0 = 0; ii0 < NC / 8; ++ii0) { const int c = wid + 8 * ii0;
        __builtin_amdgcn_global_load_lds((const unsigned*)(rowp + c * 8), (LAS unsigned*)(dst + c * 1024), 16, 0, 0); }
}
template <int DV> __device__ __forceinline__ void dma_v(LAS unsigned char* dst, const bf16_t* src, int ld, int wid, int lane) {
    constexpr int NI = DV / 8;
    const bf16_t* lp = src + (size_t)(lane >> 2) * ld + (lane & 3) * 8;
#pragma unroll
    for (int ii0 = 0; ii0 < NI / 8; ++ii0) { const int ii = wid + 8 * ii0, dblk = ii >> 2, kgrp = ii & 3;
        __builtin_amdgcn_global_load_lds((const unsigned*)(lp + (size_t)(16 * kgrp) * ld + dblk * 32), (LAS unsigned*)(dst + ii * 1024), 16, 0, 0); }
}
template <int DQK> __device__ __forceinline__ void qk_tile(f32x16& p0, f32x16& p1, const LAS unsigned char* Kt, const bf16x8* q, int r32, int hi) {
    p0 = (f32x16){}; p1 = (f32x16){};
    const LAS unsigned char* kb = Kt + hi * 1024 + r32 * 16;
    constexpr int NK = DQK / 16;
    bf16x8 a0[NK], a1[NK];
#pragma unroll
    for (int ks = 0; ks < NK; ++ks) { a0[ks] = *(const LAS bf16x8*)(kb + ks * 2048); a1[ks] = *(const LAS bf16x8*)(kb + ks * 2048 + 512); }
#pragma unroll
    for (int ks = 0; ks < NK; ++ks) { p0 = __builtin_amdgcn_mfma_f32_32x32x16_bf16(a0[ks], q[ks], p0, 0, 0, 0); p1 = __builtin_amdgcn_mfma_f32_32x32x16_bf16(a1[ks], q[ks], p1, 0, 0, 0); }
    __builtin_amdgcn_sched_group_barrier(0x100, 4, 0);
#pragma unroll
    for (int i = 0; i < NK - 2; ++i) { __builtin_amdgcn_sched_group_barrier(0x008, 2, 0); __builtin_amdgcn_sched_group_barrier(0x100, 2, 0); }
    __builtin_amdgcn_sched_group_barrier(0x008, 4, 0);
}
__device__ __forceinline__ float xhalf_max(float v) { auto rr = __builtin_amdgcn_permlane32_swap(__float_as_uint(v), __float_as_uint(v), false, false); return fmaxf(__uint_as_float(rr[0]), __uint_as_float(rr[1])); }
__device__ __forceinline__ float xhalf_sum(float v) { auto rr = __builtin_amdgcn_permlane32_swap(__float_as_uint(v), __float_as_uint(v), false, false); return __uint_as_float(rr[0]) + __uint_as_float(rr[1]); }
__device__ __forceinline__ bf16x8 pack8(const f32x16& p, int b) { u32x4 w; w.x = pk2(p[b], p[b + 1]); w.y = pk2(p[b + 2], p[b + 3]); w.z = pk2(p[b + 4], p[b + 5]); w.w = pk2(p[b + 6], p[b + 7]); return __builtin_bit_cast(bf16x8, w); }
__device__ __forceinline__ v4i16_t vtr(const LAS unsigned char* p) { return __builtin_amdgcn_ds_read_tr16_b64_v4i16((LAS v4i16_t*)p); }

template <int DV> __device__ __forceinline__ void pv_tile(f32x16* o, const LAS unsigned char* Vt, const bf16x8* pw, int lane) {
    const int hi = lane >> 5, cg = (lane >> 4) & 1, q = (lane & 15) >> 2, p = lane & 3;
    const LAS unsigned char* vb = Vt + (4 * hi + q) * 64 + 32 * cg + 8 * p;
    constexpr int NF = DV / 32 * 4;
    v4i16_t lo[NF], h8[NF];
#pragma unroll
    for (int f = 0; f < NF; ++f) { lo[f] = vtr(vb + f * 1024); h8[f] = vtr(vb + f * 1024 + 512); }
#pragma unroll
    for (int f = 0; f < NF; ++f) { const bf16x8 vf = (bf16x8){lo[f][0], lo[f][1], lo[f][2], lo[f][3], h8[f][0], h8[f][1], h8[f][2], h8[f][3]};
        o[f >> 2] = __builtin_amdgcn_mfma_f32_32x32x16_bf16(vf, pw[f & 3], o[f >> 2], 0, 0, 0); }
    __builtin_amdgcn_sched_group_barrier(0x100, 6, 0);
#pragma unroll
    for (int i = 0; i < NF - 3; ++i) { __builtin_amdgcn_sched_group_barrier(0x008, 1, 0); __builtin_amdgcn_sched_group_barrier(0x100, 2, 0); }
    __builtin_amdgcn_sched_group_barrier(0x008, 3, 0);
}
__device__ __forceinline__ float max3f_(float a, float b, float c) { return fmaxf(fmaxf(a, b), c); }
template <int DV> __device__ __forceinline__ void softmax_pv(f32x16* o, float& m, float& l, f32x16& p0, f32x16& p1, const LAS unsigned char* Vt, int lane) {
    float ra = max3f_(p0[0], p0[1], p1[0]), rb = max3f_(p0[2], p0[3], p1[1]); ra = max3f_(ra, p1[2], p1[3]);
#pragma unroll
    for (int r = 4; r < 16; r += 4) { ra = max3f_(ra, p0[r], p0[r + 1]); rb = max3f_(rb, p0[r + 2], p0[r + 3]); ra = max3f_(ra, p1[r], p1[r + 1]); rb = max3f_(rb, p1[r + 2], p1[r + 3]); }
    float rm = xhalf_max(fmaxf(ra, rb));
    if (!__all(m == 0.f)) { rm -= m;
#pragma unroll
        for (int r = 0; r < 16; ++r) { p0[r] -= m; p1[r] -= m; } }
    if (__any(rm > 8.f)) { const float dl = fmaxf(rm, 0.f), alpha = __builtin_amdgcn_exp2f(-dl); m += dl; l *= alpha;
#pragma unroll
        for (int r = 0; r < 16; ++r) { p0[r] -= dl; p1[r] -= dl; }
#pragma unroll
        for (int dt = 0; dt < DV / 32; ++dt) o[dt] = o[dt] * alpha; }
    float ps = 0.f, ps2 = 0.f;
#pragma unroll
    for (int r = 0; r < 16; ++r) { p0[r] = __builtin_amdgcn_exp2f(p0[r]); p1[r] = __builtin_amdgcn_exp2f(p1[r]); ps += p0[r]; ps2 += p1[r]; }
    l += ps + ps2;
    bf16x8 pw[4]; pw[0] = pack8(p0, 0); pw[1] = pack8(p0, 8); pw[2] = pack8(p1, 0); pw[3] = pack8(p1, 8);
    pv_tile<DV>(o, Vt, pw, lane);
}
__device__ __forceinline__ int crow(int r, int hi) { return (r & 3) + 8 * (r >> 2) + 4 * hi; }
#define ATT_SYNC() do { asm volatile("s_waitcnt vmcnt(0)" ::: "memory"); __syncthreads(); } while (0)

template <int DQK, int DV, int NK, class MaskF>
__device__ __forceinline__ void attn_stream(LAS unsigned char* lds, unsigned tm, const bf16_t* Kg, int ldk, int kstride2, const bf16_t* Vg, int ldv, int ksel,
                                            const bf16x8* q, f32x16* o, float& m, float& l, const MaskF& mask, int wid, int lane) {
    const int r32 = lane & 31, hi = lane >> 5;
    if (tm == 0u) return;
    int j = __builtin_ctz(tm); tm &= tm - 1; int buf = 0;
#pragma unroll
    for (int k = 0; k < NK; ++k) dma_k<DQK>(lds + k * (64 * DQK * 2), Kg + (size_t)(64 * j) * ldk + k * kstride2, ldk, wid, lane);
    dma_v<DV>(lds + 16384, Vg + (size_t)(64 * j) * ldv, ldv, wid, lane);
    for (;;) {
        ATT_SYNC();
        int jn = -1;
        if (tm) { jn = __builtin_ctz(tm); tm &= tm - 1; LAS unsigned char* nb = lds + (buf ^ 1) * ATT_STAGE;
#pragma unroll
            for (int k = 0; k < NK; ++k) dma_k<DQK>(nb + k * (64 * DQK * 2), Kg + (size_t)(64 * jn) * ldk + k * kstride2, ldk, wid, lane);
            dma_v<DV>(nb + 16384, Vg + (size_t)(64 * jn) * ldv, ldv, wid, lane); }
        const LAS unsigned char* cb = lds + buf * ATT_STAGE;
        f32x16 p0, p1;
        qk_tile<DQK>(p0, p1, cb + ksel * (64 * DQK * 2), q, r32, hi);
        mask(p0, p1, j);
        softmax_pv<DV>(o, m, l, p0, p1, cb + 16384, lane);
        if (jn < 0) break;
        j = jn; buf ^= 1;
    }
    __syncthreads();
}
template <int DQK> __device__ __forceinline__ void load_q(bf16x8* q, const bf16_t* Qrow, int hi) {
#pragma unroll
    for (int ks = 0; ks < DQK / 16; ++ks) q[ks] = *(const bf16x8*)(Qrow + 16 * ks + 8 * hi);
}
__device__ __forceinline__ void store16_pair(bf16_t* rowp, int hi, u32x2 a, u32x2 b) {
    auto r0 = __builtin_amdgcn_permlane32_swap(a.x, b.x, false, false); auto r1 = __builtin_amdgcn_permlane32_swap(a.y, b.y, false, false);
    *(u32x4*)(rowp + (hi ? 8 : 0)) = (u32x4){r0[0], r1[0], r0[1], r1[1]};
}
template <int DV> __device__ __forceinline__ void store_o(bf16_t* Orow, const f32x16* o, float scale, int hi) {
#pragma unroll
    for (int dt = 0; dt < DV / 32; ++dt)
#pragma unroll
        for (int kp = 0; kp < 2; ++kp) { u32x2 a, b2; const int r0 = 8 * kp;
            a.x = pk2(o[dt][r0] * scale, o[dt][r0 + 1] * scale); a.y = pk2(o[dt][r0 + 2] * scale, o[dt][r0 + 3] * scale);
            b2.x = pk2(o[dt][r0 + 4] * scale, o[dt][r0 + 5] * scale); b2.y = pk2(o[dt][r0 + 6] * scale, o[dt][r0 + 7] * scale);
            store16_pair(Orow + 32 * dt + 16 * kp, hi, a, b2); }
}

__device__ __forceinline__ void mask_apply(f32x16& p0, f32x16& p1, int d, int lo) {
#pragma unroll
    for (int r = 0; r < 16; ++r) { const int C = (r & 3) + 8 * (r >> 2); if (C > d || C <= lo) p0[r] = -INFINITY; if (C + 32 > d || C + 32 <= lo) p1[r] = -INFINITY; }
}
struct MaskWin { int qrow, W, hi; __device__ __forceinline__ void operator()(f32x16& p0, f32x16& p1, int j) const {
    const int qmin = __builtin_amdgcn_readfirstlane(qrow), kb = 64 * j;
    if (kb + 63 <= qmin && kb > qmin + 31 - W) return;
    const int d = qrow - kb - 4 * hi; mask_apply(p0, p1, d, d - W); } };
struct MaskNone { __device__ __forceinline__ void operator()(f32x16&, f32x16&, int) const {} };
struct MaskSel { int qrow; unsigned sel; int hi; __device__ __forceinline__ void operator()(f32x16& p0, f32x16& p1, int j) const {
    const int qmin = __builtin_amdgcn_readfirstlane(qrow), kb = 64 * j; const bool on = (sel >> j) & 1u;
    if (kb + 63 <= qmin && __all(on)) return;
    const int d = on ? (qrow - kb - 4 * hi) : -1; mask_apply(p0, p1, d, -(1 << 30)); } };

__device__ __forceinline__ void attn_item_swa(LAS unsigned char* lds, unsigned char* ws, const float* sinks, int b, int kvh, int qb, int wid, int lane) {
    const int r32 = lane & 31, hi = lane >> 5, head = kvh * 4 + (wid >> 1), qrow = qb * 64 + 32 * (wid & 1) + r32; const size_t tok = (size_t)b * SEQ + qrow;
    bf16x8 q[4]; load_q<64>(q, (const bf16_t*)(ws + WS_QA) + tok * 512 + head * 64, hi);
    f32x16 o[2]; o[0] = (f32x16){}; o[1] = (f32x16){};
    float m = sinks[head] * LOG2E, l = hi == 0 ? 1.f : 0.f;
    unsigned tm = 0; for (int j = (qb >= 2 ? qb - 2 : 0); j <= qb; ++j) tm |= 1u << j;
    MaskWin mk{qrow, 128, hi};
    attn_stream<64, 64, 1>(lds, tm, (const bf16_t*)(ws + WS_KA) + (size_t)b * SEQ * 128 + kvh * 64, 128, 0, (const bf16_t*)(ws + WS_VA) + (size_t)b * SEQ * 128 + kvh * 64, 128, 0, q, o, m, l, mk, wid, lane);
    l = xhalf_sum(l);
    store_o<64>((bf16_t*)(ws + WS_OCAT) + tok * DM + head * 64, o, 1.f / l, hi);
}

__device__ __forceinline__ void attn_item_cross(LAS unsigned char* lds, unsigned char* ws, int b, int h, int qb, int wid, int lane) {
    const int r32 = lane & 31, hi = lane >> 5, qrow = qb * 256 + 32 * wid + r32; const size_t tok = (size_t)b * SEQ + qrow;
    bf16x8 q[8]; load_q<128>(q, (const bf16_t*)(ws + WS_QX) + tok * 512 + h * 128, hi);
    f32x16 o[4]; o[0] = (f32x16){}; o[1] = (f32x16){}; o[2] = (f32x16){}; o[3] = (f32x16){};
    float m = 0.f, l = 0.f; MaskNone mk;
    const bf16_t* kv = (const bf16_t*)(ws + WS_KVM) + (size_t)b * NMEM * 1024 + h * 128;
    attn_stream<128, 128, 1>(lds, 0xFu, kv, 1024, 0, kv + 512, 1024, 0, q, o, m, l, mk, wid, lane);
    l = xhalf_sum(l);
    store_o<128>((bf16_t*)(ws + WS_OX) + tok * 512 + h * 128, o, 1.f / l, hi);
}

__device__ __forceinline__ void attn_item_diff(LAS unsigned char* lds, unsigned char* ws, const float* g_sub, float lam, float lambda_init, int b, int h, int qb, int wid, int lane) {
    const int r32 = lane & 31, hi = lane >> 5, comp = wid >> 2, qrow = qb * 128 + 32 * (wid & 3) + r32; const size_t tok = (size_t)b * SEQ + qrow;
    bf16x8 q[4]; load_q<64>(q, (const bf16_t*)(ws + WS_QC) + tok * 512 + (h * 2 + comp) * 64, hi);
    f32x16 o[4]; o[0] = (f32x16){}; o[1] = (f32x16){}; o[2] = (f32x16){}; o[3] = (f32x16){};
    float m = 0.f, l = 0.f;
    const int nt = 2 * qb + 2; const unsigned tm = (nt >= 32) ? 0xFFFFFFFFu : ((1u << nt) - 1u);
    MaskWin mk{qrow, 1 << 28, hi};
    attn_stream<64, 128, 2>(lds, tm, (const bf16_t*)(ws + WS_KC) + (size_t)b * SEQ * 512 + h * 128, 512, 64, (const bf16_t*)(ws + WS_VC) + (size_t)b * SEQ * 512 + h * 128, 512, comp, q, o, m, l, mk, wid, lane);
    l = xhalf_sum(l); const float il = 1.f / l;
    LAS float* xp = (LAS float*)(lds + ATT_X) + (wid & 3) * 4096 + lane;
    if (comp == 1) {
#pragma unroll
        for (int dt = 0; dt < 4; ++dt)
#pragma unroll
            for (int r = 0; r < 16; ++r) xp[(dt * 16 + r) * 64] = o[dt][r] * il;
    }
    __syncthreads();
    if (comp == 0) {
        float ss = 0.f;
#pragma unroll
        for (int dt = 0; dt < 4; ++dt)
#pragma unroll
            for (int r = 0; r < 16; ++r) { const float v = o[dt][r] * il - lam * xp[(dt * 16 + r) * 64]; o[dt][r] = v; ss += v * v; }
        ss = xhalf_sum(ss);
        const float rs = rsqrtf(ss * (1.f / 128.f) + EPS) * (1.f - lambda_init); const float* gsb = g_sub + 4 * hi;
#pragma unroll
        for (int dt = 0; dt < 4; ++dt)
#pragma unroll
            for (int r = 0; r < 16; ++r) o[dt][r] *= gsb[32 * dt + (r & 3) + 8 * (r >> 2)];
        store_o<128>((bf16_t*)(ws + WS_OCAT) + tok * DM + 1536 + h * 128, o, rs, hi);
    }
    __syncthreads();
}

__device__ __forceinline__ void attn_item_nsa(LAS unsigned char* lds, unsigned char* ws, int layer, int b, int g, int qb, int wid, int lane) {
    const int tid = wid * 64 + lane, r32 = lane & 31, hi = lane >> 5, hs = wid >> 1, head = g * 4 + hs, ql = 32 * (wid & 1) + r32, qrow = qb * 64 + ql; const size_t tok = (size_t)b * SEQ + qrow;
    bf16x8 q[8]; load_q<128>(q, (const bf16_t*)(ws + WS_QB) + tok * 1024 + head * 128, hi);
    const float* gb = (const float*)(ws + WS_GATEB) + tok * 32 + head * 3; const float g0 = gb[0], g1 = gb[1], g2 = gb[2];
    LAS float* Gs = (LAS float*)(lds + ATT_X);
    LAS float* Es = Gs + 4 * 32 * 64;
    LAS float* IMP = (LAS float*)(lds);
    LAS unsigned* SEL = (LAS unsigned*)(lds + 16384);
    u32x4 opk[8];
    {
        const bf16_t* kc = (const bf16_t*)(ws + WS_KCMP + (size_t)layer * 512 * 1024) + (size_t)(b * 2 + g) * 128 * 128; const bf16_t* vc = (const bf16_t*)(ws + WS_VCMP + (size_t)layer * 512 * 1024) + (size_t)(b * 2 + g) * 128 * 128;
        dma_k<128>(lds, kc, 128, wid, lane); dma_v<128>(lds + 16384, vc, 128, wid, lane);
        dma_k<128>(lds + ATT_STAGE, kc + 64 * 128, 128, wid, lane); dma_v<128>(lds + ATT_STAGE + 16384, vc + 64 * 128, 128, wid, lane);
        ATT_SYNC();
        f32x16 s[4];
        qk_tile<128>(s[0], s[1], lds, q, r32, hi); qk_tile<128>(s[2], s[3], lds + ATT_STAGE, q, r32, hi);
        float rm = -1e30f; const int dcm = qrow - 64 * hi - 31;
#pragma unroll
        for (int t = 0; t < 4; ++t)
#pragma unroll
            for (int r = 0; r < 16; ++r) { const int C16 = 512 * t + 16 * ((r & 3) + 8 * (r >> 2)); bool ok = (C16 <= dcm); if (t == 3 && r == 15) ok = ok && (hi == 0);
                s[t][r] = ok ? s[t][r] : -INFINITY; rm = fmaxf(rm, s[t][r]); }
        rm = xhalf_max(rm); float ps = 0.f;
#pragma unroll
        for (int t = 0; t < 4; ++t)
#pragma unroll
            for (int r = 0; r < 16; ++r) { s[t][r] = __builtin_amdgcn_exp2f(s[t][r] - rm); ps += s[t][r]; }
        ps = xhalf_sum(ps); const float inv = ps > 0.f ? 1.f / ps : 0.f;
        LAS float* gsp = Gs + (hs * 32 + hi) * 64 + ql;
#pragma unroll
        for (int t = 0; t < 4; ++t) {
#pragma unroll
            for (int r = 0; r < 16; ++r) s[t][r] *= inv;
#pragma unroll
            for (int r4 = 0; r4 < 4; ++r4) { gsp[(8 * t + 2 * r4) * 64] = (s[t][4 * r4] + s[t][4 * r4 + 1]) + (s[t][4 * r4 + 2] + s[t][4 * r4 + 3]); gsp[8192 + (8 * t + 2 * r4) * 64] = s[t][4 * r4 + 3]; }
        }
        f32x16 o[4]; o[0] = (f32x16){}; o[1] = (f32x16){}; o[2] = (f32x16){}; o[3] = (f32x16){};
        { bf16x8 pw[4]; pw[0] = pack8(s[0], 0); pw[1] = pack8(s[0], 8); pw[2] = pack8(s[1], 0); pw[3] = pack8(s[1], 8); pv_tile<128>(o, lds + 16384, pw, lane);
          pw[0] = pack8(s[2], 0); pw[1] = pack8(s[2], 8); pw[2] = pack8(s[3], 0); pw[3] = pack8(s[3], 8); pv_tile<128>(o, lds + ATT_STAGE + 16384, pw, lane); }
#pragma unroll
        for (int dt = 0; dt < 4; ++dt) { opk[2 * dt].x = pk2(o[dt][0] * g0, o[dt][1] * g0); opk[2 * dt].y = pk2(o[dt][2] * g0, o[dt][3] * g0); opk[2 * dt].z = pk2(o[dt][4] * g0, o[dt][5] * g0); opk[2 * dt].w = pk2(o[dt][6] * g0, o[dt][7] * g0);
            opk[2 * dt + 1].x = pk2(o[dt][8] * g0, o[dt][9] * g0); opk[2 * dt + 1].y = pk2(o[dt][10] * g0, o[dt][11] * g0); opk[2 * dt + 1].z = pk2(o[dt][12] * g0, o[dt][13] * g0); opk[2 * dt + 1].w = pk2(o[dt][14] * g0, o[dt][15] * g0); }
    }
    __syncthreads();
    if (tid == 0) SEL[64] = 0u;
#pragma unroll
    for (int it = 0; it < 4; ++it) { const int idx = tid + 512 * it, qq = idx & 63, j = idx >> 6;
        float v = 0.f;
#pragma unroll
        for (int h4 = 0; h4 < 4; ++h4) { v += Gs[(h4 * 32 + j) * 64 + qq]; if (j > 0) v += Es[(h4 * 32 + j - 1) * 64 + qq]; }
        const bool future = j > qb, forced = (j == 0) || (j == qb) || (j == qb - 1);
        IMP[qq * 33 + j] = future ? -1.0f : (forced ? 1e6f : v); }
    __syncthreads();
#pragma unroll
    for (int it = 0; it < 4; ++it) { const int idx = tid + 512 * it, qq = idx >> 5, j = idx & 31; const float vj = IMP[qq * 33 + j]; int cnt = 0;
#pragma unroll 8
        for (int i = 0; i < 32; ++i) { const float vi = IMP[qq * 33 + i]; cnt += (vi > vj || (vi == vj && i < j)) ? 1 : 0; }
        const unsigned long long bal = __ballot(cnt < 8);
        const unsigned mine = (lane < 32) ? (unsigned)bal : (unsigned)(bal >> 32);
        if ((lane & 31) == 0) { SEL[qq] = mine; atomicOr((unsigned*)&SEL[64], mine); } }
    __syncthreads();
    const unsigned sel = SEL[ql]; const unsigned live = (qb >= 31) ? 0xFFFFFFFFu : ((1u << (qb + 1)) - 1u); const unsigned un = SEL[64] & live;
    LAS unsigned* xo = (LAS unsigned*)(lds + ATT_X) + wid * 2048 + lane;
#pragma unroll
    for (int k = 0; k < 8; ++k) { xo[(4 * k) * 64] = opk[k].x; xo[(4 * k + 1) * 64] = opk[k].y; xo[(4 * k + 2) * 64] = opk[k].z; xo[(4 * k + 3) * 64] = opk[k].w; }
    __syncthreads();
    load_q<128>(q, (const bf16_t*)(ws + WS_QB) + tok * 1024 + head * 128, hi);
    {
        f32x16 o[4]; o[0] = (f32x16){}; o[1] = (f32x16){}; o[2] = (f32x16){}; o[3] = (f32x16){};
        float m = 0.f, l = 0.f; MaskSel mk{qrow, sel, hi};
        attn_stream<128, 128, 1>(lds, un, (const bf16_t*)(ws + WS_KSB) + (size_t)b * SEQ * 256 + g * 128, 256, 0, (const bf16_t*)(ws + WS_VSB) + (size_t)b * SEQ * 256 + g * 128, 256, 0, q, o, m, l, mk, wid, lane);
        l = xhalf_sum(l); const float sc = g1 / l;
#pragma unroll
        for (int dt = 0; dt < 4; ++dt)
#pragma unroll
            for (int k = 0; k < 8; ++k) { const unsigned w = xo[(8 * dt + k) * 64]; xo[(8 * dt + k) * 64] = pk2(bf2f(w & 0xffff) + o[dt][2 * k] * sc, bf2f(w >> 16) + o[dt][2 * k + 1] * sc); }
    }
    {
        f32x16 o[4]; o[0] = (f32x16){}; o[1] = (f32x16){}; o[2] = (f32x16){}; o[3] = (f32x16){};
        float m = 0.f, l = 0.f; MaskWin mk{qrow, 512, hi};
        unsigned tm = 0; for (int j = (qb >= 8 ? qb - 8 : 0); j <= qb; ++j) tm |= 1u << j;
        attn_stream<128, 128, 1>(lds, tm, (const bf16_t*)(ws + WS_KWB) + (size_t)b * SEQ * 256 + g * 128, 256, 0, (const bf16_t*)(ws + WS_VWB) + (size_t)b * SEQ * 256 + g * 128, 256, 0, q, o, m, l, mk, wid, lane);
        l = xhalf_sum(l); const float sc = g2 / l;
        bf16_t* Orow = (bf16_t*)(ws + WS_OCAT) + tok * DM + 512 + head * 128;
#pragma unroll
        for (int dt = 0; dt < 4; ++dt)
#pragma unroll
            for (int kp = 0; kp < 2; ++kp) { u32x2 ab[2];
#pragma unroll
                for (int h2 = 0; h2 < 2; ++h2) { const int r4 = 2 * kp + h2; const unsigned w0 = xo[(8 * dt + 2 * r4) * 64], w1 = xo[(8 * dt + 2 * r4 + 1) * 64];
                    ab[h2].x = pk2(bf2f(w0 & 0xffff) + o[dt][4 * r4] * sc, bf2f(w0 >> 16) + o[dt][4 * r4 + 1] * sc); ab[h2].y = pk2(bf2f(w1 & 0xffff) + o[dt][4 * r4 + 2] * sc, bf2f(w1 >> 16) + o[dt][4 * r4 + 3] * sc); }
                store16_pair(Orow + 32 * dt + 16 * kp, hi, ab[0], ab[1]); }
        __syncthreads();
    }
}

__device__ __forceinline__ void compress_item(LAS unsigned char* lds, unsigned char* ws, int layer, int kv, int bg, int rg, int wid, int lane) {
    const int r32 = lane & 31, hi = lane >> 5, ntile = wid & 3, khalf = wid >> 2;
    const bf16_t* src = (const bf16_t*)(ws + (kv ? WS_VCB : WS_KCB)) + (size_t)bg * SEQ * 128 + (size_t)(32 * rg + r32) * 2048 + khalf * 2048 + 8 * hi;
    const bf16_t* w1 = (const bf16_t*)(ws + WS_PHI1) + (size_t)((layer * 2 + kv) * 128 + 32 * ntile + r32) * 4096 + khalf * 2048 + 8 * hi;
    f32x16 acc = (f32x16){};
#pragma unroll 16
    for (int ks = 0; ks < 128; ++ks) { const bf16x8 a = *(const bf16x8*)(src + 16 * ks), bw = *(const bf16x8*)(w1 + 16 * ks); acc = __builtin_amdgcn_mfma_f32_32x32x16_bf16(a, bw, acc, 0, 0, 0); }
    LAS float* RED = (LAS float*)lds;
    LAS bf16_t* HID = (LAS bf16_t*)(lds + 16384);
    if (khalf == 1) {
#pragma unroll
        for (int r = 0; r < 16; ++r) RED[(ntile * 16 + r) * 64 + lane] = acc[r]; }
    __syncthreads();
    if (khalf == 0) { const f32x4 b4 = ((const f32x4*)(ws + WS_CBIAS))[(layer * 2 + kv) * 128 + 32 * ntile + r32]; const float bias = (b4[0] + b4[1]) + (b4[2] + b4[3]);
#pragma unroll
        for (int r = 0; r < 16; ++r) { float v = acc[r] + RED[(ntile * 16 + r) * 64 + lane] + bias; v = v * sigmoidf_(v); HID[crow(r, hi) * 136 + 32 * ntile + r32] = (bf16_t)f2bf(v); } }
    __syncthreads();
    if (khalf == 0) { const bf16_t* w2 = (const bf16_t*)(ws + WS_PHI2) + (size_t)((layer * 2 + kv) * 128 + 32 * ntile + r32) * 128 + 8 * hi; f32x16 o2 = (f32x16){};
#pragma unroll
        for (int ks = 0; ks < 8; ++ks) { const bf16x8 a = *(const LAS bf16x8*)(HID + r32 * 136 + 16 * ks + 8 * hi), bw = *(const bf16x8*)(w2 + 16 * ks); o2 = __builtin_amdgcn_mfma_f32_32x32x16_bf16(a, bw, o2, 0, 0, 0); }
        bf16_t* dst = (bf16_t*)(ws + (kv ? WS_VCMP : WS_KCMP) + (size_t)layer * 512 * 1024) + (size_t)bg * 128 * 128;
#pragma unroll
        for (int r = 0; r < 16; ++r) { const int c = 32 * rg + crow(r, hi); __hip_atomic_store(dst + c * 128 + 32 * ntile + r32, (c < 127) ? (bf16_t)f2bf(o2[r]) : (bf16_t)0, __ATOMIC_RELAXED, __HIP_MEMORY_SCOPE_AGENT); } }
    __syncthreads();
}

template <bool COMB, bool WRX, int OUTM, bool XBF = false>
__device__ __forceinline__ void rms_row(const void* xrow, void* xwr, const float* g, void* orow, const bf16_t* y0, const bf16_t* y1, float w0, float w1, int lane, void* orow8 = nullptr) {
    float v[4][8]; float s = 0.f;
#pragma unroll
    for (int j = 0; j < 4; ++j) { const int e0 = 512 * j + 8 * lane;
        if (XBF) { const u32x4 xx = *(const u32x4*)((const bf16_t*)xrow + e0);
#pragma unroll
            for (int k = 0; k < 4; ++k) { v[j][2 * k] = bf2f(xx[k] & 0xffff); v[j][2 * k + 1] = bf2f(xx[k] >> 16); } }
        else { const f32x4 a = *(const f32x4*)((const float*)xrow + e0), b = *(const f32x4*)((const float*)xrow + e0 + 4);
#pragma unroll
            for (int k = 0; k < 4; ++k) { v[j][k] = a[k]; v[j][4 + k] = b[k]; } }
        if (COMB) { const u32x4 a = *(const u32x4*)(y0 + e0), b = *(const u32x4*)(y1 + e0);
#pragma unroll
            for (int k = 0; k < 4; ++k) { v[j][2 * k] += w0 * bf2f(a[k] & 0xffff) + w1 * bf2f(b[k] & 0xffff); v[j][2 * k + 1] += w0 * bf2f(a[k] >> 16) + w1 * bf2f(b[k] >> 16); } }
        if (WRX) { u32x4 wx;
#pragma unroll
            for (int k = 0; k < 4; ++k) wx[k] = pk2(v[j][2 * k], v[j][2 * k + 1]);
            *(u32x4*)((bf16_t*)xwr + e0) = wx; }
#pragma unroll
        for (int k = 0; k < 8; k += 2) s += v[j][k] * v[j][k] + v[j][k + 1] * v[j][k + 1]; }
    const float rs = rsqrtf(wave_sum(s) * (1.f / DM) + EPS);
#pragma unroll
    for (int j = 0; j < 4; ++j) { const int e0 = 512 * j + 8 * lane; const f32x4 g0 = *(const f32x4*)(g + e0), g1 = *(const f32x4*)(g + e0 + 4);
        float o[8];
#pragma unroll
        for (int k = 0; k < 4; ++k) { o[k] = v[j][k] * rs * g0[k]; o[4 + k] = v[j][4 + k] * rs * g1[k]; }
        if (OUTM == 1) { __builtin_nontemporal_store((f32x4){o[0], o[1], o[2], o[3]}, (f32x4*)((float*)orow + e0)); __builtin_nontemporal_store((f32x4){o[4], o[5], o[6], o[7]}, (f32x4*)((float*)orow + e0 + 4)); }
        else {
            if (OUTM >= 2) { u32x2 w8; w8.x = pk4_fp8(o[0] * SA8, o[1] * SA8, o[2] * SA8, o[3] * SA8); w8.y = pk4_fp8(o[4] * SA8, o[5] * SA8, o[6] * SA8, o[7] * SA8); *(u32x2*)((unsigned char*)orow8 + e0) = w8; }
            if (OUTM == 2) continue;
            u32x4 w;
#pragma unroll
            for (int k = 0; k < 4; ++k) w[k] = pk2(o[2 * k], o[2 * k + 1]);
            *(u32x4*)((bf16_t*)orow + e0) = w; }
    }
}
__device__ __forceinline__ void rms_row_bf16(const float* xrow, const float* g, bf16_t* orow, int lane) { rms_row<false, false, 0>(xrow, nullptr, g, orow, nullptr, nullptr, 0.f, 0.f, lane); }
__device__ __forceinline__ void moe_row_src(unsigned char* ws, const volatile LAS int* tab, int r, const bf16_t*& y0, const bf16_t*& y1, float& w0, float& w1) {
    const int* rt = (const int*)(ws + WS_WT) + (size_t)r * 4; const float* rw = (const float*)(ws + WS_WT + 512 * 1024) + (size_t)r * 2;
    const int e0 = __builtin_amdgcn_readfirstlane(rt[0]), r0 = __builtin_amdgcn_readfirstlane(rt[1]), e1 = __builtin_amdgcn_readfirstlane(rt[2]), r1 = __builtin_amdgcn_readfirstlane(rt[3]);
    const int s0 = __builtin_amdgcn_readfirstlane(tab[e0]) * 256 + r0, s1 = __builtin_amdgcn_readfirstlane(tab[e1]) * 256 + r1;
    y0 = (const bf16_t*)(ws + WS_Y) + (size_t)s0 * DM; y1 = (const bf16_t*)(ws + WS_Y) + (size_t)s1 * DM; w0 = rw[0]; w1 = rw[1];
}
struct TrDesc { const float* sp; bf16_t* dp; unsigned lds_, ldd; int nvalid; float f8s; const float* rs; int kp; };
__device__ __forceinline__ TrDesc tr_desc(const float* src, size_t lds_, int k0, int sc0, int nvalid, bf16_t* dst, size_t ldd, size_t drow0, int dk0) {
    TrDesc d; d.sp = src + (size_t)k0 * lds_ + sc0; d.dp = dst + drow0 * ldd + dk0; d.lds_ = (unsigned)lds_; d.ldd = (unsigned)ldd; d.nvalid = nvalid; d.f8s = 0.f; d.rs = nullptr; d.kp = -1; return d;
}
__device__ __forceinline__ void tr_load(const TrDesc& d, f32x4 (&v)[8], float (&gs)[8], int lane) {
    const int r = lane >> 3, c4 = (lane & 7) * 4; const float* sp = d.sp + (size_t)r * d.lds_ + c4;
#pragma unroll
    for (int i = 0; i < 8; ++i) gs[i] = d.rs ? d.rs[8 * i + r] : 1.f;
#pragma unroll
    for (int i = 0; i < 8; ++i) v[i] = (c4 < d.nvalid) ? __builtin_nontemporal_load((const f32x4*)(sp + (size_t)(8 * i) * d.lds_)) : (f32x4){0.f, 0.f, 0.f, 0.f};
}
__device__ __forceinline__ void tr_store(const TrDesc& d, const f32x4 (&v)[8], const float (&gs)[8], LAS float* scr, int lane) {
    const int r = lane >> 3, c4 = (lane & 7) * 4;
#pragma unroll
    for (int i = 0; i < 8; ++i) { LAS float* w = scr + (8 * i + r) * 33 + c4; w[0] = v[i][0] * gs[i]; w[1] = v[i][1] * gs[i]; w[2] = v[i][2] * gs[i]; w[3] = v[i][3] * gs[i]; }
    asm volatile("s_waitcnt lgkmcnt(0)" ::: "memory");
    const int c = lane & 7;
#pragma unroll
    for (int j = 0; j < 4; ++j) { const int n = (lane >> 3) + 8 * j; const LAS float* s = scr + (8 * c) * 33 + n;
        if (d.f8s != 0.f) { const float q = d.f8s; u32x2 o8; int koff = 8 * c;
            if (d.kp >= 0) { const int k = d.kp + 8 * c, kk = k & 255; koff = (k & ~255) + ((kk >> 5) & 3) * 64 + ((kk >> 3) & 3) * 16 + (kk >> 7) * 8 - d.kp; }     o8.x = pk4_fp8(s[0 * 33] * q, s[1 * 33] * q, s[2 * 33] * q, s[3 * 33] * q); o8.y = pk4_fp8(s[4 * 33] * q, s[5 * 33] * q, s[6 * 33] * q, s[7 * 33] * q);
            __builtin_nontemporal_store(o8, (u32x2*)((unsigned char*)d.dp + (size_t)n * d.ldd + koff)); }
        else { u32x4 o; o.x = pk2(s[0 * 33], s[1 * 33]); o.y = pk2(s[2 * 33], s[3 * 33]); o.z = pk2(s[4 * 33], s[5 * 33]); o.w = pk2(s[6 * 33], s[7 * 33]);
            __builtin_nontemporal_store(o, (u32x4*)(d.dp + (size_t)n * d.ldd + 8 * c)); } }
    asm volatile("s_waitcnt lgkmcnt(0)" ::: "memory");
}
__device__ __forceinline__ int inproj_src(int vn0, int& nvalid) {
    const int t = vn0 >> 8, r = vn0 & 255, bj = r >> 7, qd = r & 127; nvalid = 32;
    int base; bool d128;
    if (t < 2) { base = t * 256; d128 = false; }
    else if (t == 2) { base = 512; d128 = false; }
    else if (t < 7) { base = 768 + (t - 3) * 256; d128 = true; }
    else if (t < 13) { base = 1792 + (t - 7) * 256; d128 = true; }
    else if (t < 15) { base = 3352 + (t - 13) * 256; d128 = false; }
    else if (t < 17) { base = 3864 + (t - 15) * 256; d128 = false; }
    else if (t < 19) { base = 4376 + (t - 17) * 256; d128 = true; }
    else if (t == 19) { if (r == 0) { nvalid = 24; return 3328; } nvalid = 0; return 0; }
    else return 4888 + (t - 20) * 256 + r;
    if (d128) { const int hh = qd >> 6, i = qd & 63; return base + hh * 128 + bj * 64 + i; }
    const int hh = qd >> 5, i = qd & 31; return base + hh * 64 + bj * 32 + i;
}

struct Args { const void* in[35]; float* out; unsigned char* ws; int ph_lo, ph_hi; };

__device__ __forceinline__ TrDesc desc_small(const __attribute__((address_space(4))) Args* a, int l, int it) {
    unsigned char* ws = a->ws;
    if (it < 32 * 352) { const int kb = it / 352, ng = it % 352; int nv; const int sc = inproj_src(ng * 32, nv);
        bool f8; const int lt = local_of_tile(ng >> 3, f8), lrow = lt * 256 + (ng & 7) * 32;
        TrDesc d = tr_desc((const float*)a->in[4] + (size_t)l * DM * INW, INW, kb * 64, sc, nv, (bf16_t*)(ws + WS_WIN) + (size_t)l * NV16 * DM, DM, lrow, kb * 64);
        if (f8) { d.dp = (bf16_t*)(ws + WS_WIN8 + (size_t)l * NV8 * DM + (size_t)lrow * DM + kb * 64); d.f8s = SW8; }
        return d; } it -= 32 * 352;
    if (it < 8 * 64) { const int kb = it / 64, ng = it % 64; return tr_desc((const float*)a->in[17] + (size_t)l * 512 * DM, DM, kb * 64, ng * 32, 32, (bf16_t*)(ws + WS_WPCAT) + (size_t)l * DM * DM, DM, ng * 32, kb * 64); } it -= 8 * 64;
    if (it < 16 * 64) { const int kb = it / 64, ng = it % 64; return tr_desc((const float*)a->in[18] + (size_t)l * 1024 * DM, DM, kb * 64, ng * 32, 32, (bf16_t*)(ws + WS_WPCAT) + (size_t)l * DM * DM, DM, ng * 32, 512 + kb * 64); } it -= 16 * 64;
    if (it < 8 * 64) { const int kb = it / 64, ng = it % 64; return tr_desc((const float*)a->in[19] + (size_t)l * 512 * DM, DM, kb * 64, ng * 32, 32, (bf16_t*)(ws + WS_WPCAT) + (size_t)l * DM * DM, DM, ng * 32, 1536 + kb * 64); } it -= 8 * 64;
    if (it < 32 * 64) { const int kb = it / 64, ng = it % 64; TrDesc d = tr_desc((const float*)a->in[20] + (size_t)l * DM * DM, DM, kb * 64, ng * 32, 32, (bf16_t*)(ws + WS_WOUT) + (size_t)l * DM * DM, DM, ng * 32, kb * 64);
        if (F_F8) { d.dp = (bf16_t*)(ws + WS_WOUT + (size_t)l * DM * DM + (size_t)(ng * 32) * DM + kb * 64); d.f8s = SW8; d.kp = kb * 64; }
        return d; } it -= 32 * 64;
    if (it < 32 * 16) { const int kb = it / 16, ng = it % 16; TrDesc d = tr_desc((const float*)a->in[23] + (size_t)l * DM * 512, 512, kb * 64, ng * 32, 32, (bf16_t*)(ws + WS_WXCAT) + (size_t)l * 1536 * DM, DM, ng * 32, kb * 64);
        d.rs = (const float*)a->in[21] + (size_t)l * DM + kb * 64; return d; } it -= 32 * 16;
    if (it < 32 * 32) { const int kb = it / 32, ng = it % 32; return tr_desc((const float*)a->in[24] + (size_t)l * DM * 1024, 1024, kb * 64, ng * 32, 32, (bf16_t*)(ws + WS_WXCAT) + (size_t)l * 1536 * DM, DM, 512 + ng * 32, kb * 64); } it -= 32 * 32;
    if (it < 8 * 64) { const int kb = it / 64, ng = it % 64; return tr_desc((const float*)a->in[25] + (size_t)l * 512 * DM, DM, kb * 64, ng * 32, 32, (bf16_t*)(ws + WS_WXO) + (size_t)l * DM * 512, 512, ng * 32, kb * 64); } it -= 8 * 64;
    if (it < 2 * 64 * 4) { const int kv = it / 256, r = it % 256, kb = r / 4, ng = r % 4; return tr_desc((const float*)a->in[kv ? 10 : 8] + (size_t)l * 4096 * 128, 128, kb * 64, ng * 32, 32, (bf16_t*)(ws + WS_PHI1) + (size_t)(l * 2 + kv) * 128 * 4096, 4096, ng * 32, kb * 64); } it -= 512;
    { const int kv = it / 8, r = it % 8, kb = r / 4, ng = r % 4; return tr_desc((const float*)a->in[kv ? 11 : 9] + (size_t)l * 128 * 128, 128, kb * 64, ng * 32, 32, (bf16_t*)(ws + WS_PHI2) + (size_t)(l * 2 + kv) * 128 * 128, 128, ng * 32, kb * 64); }
}
constexpr int N_SMALL_ITEMS = 32 * 352 + 512 + 1024 + 512 + 2048 + 512 + 1024 + 512 + 512 + 16;
constexpr int N_MOE_ITEMS = NEXP * (32 * 64 + 16 * 64);
__device__ __forceinline__ TrDesc desc_moe(const __attribute__((address_space(4))) Args* a, int l, int it) {
    unsigned char* ws = a->ws; const int e = it / 3072; int r = it % 3072;
    if (r < 2048) { const int kb = r / 64, ng = r % 64, vn0 = ng * 32, pnl = vn0 >> 8, bj = (vn0 >> 7) & 1, c = vn0 & 127;
        TrDesc d = tr_desc((const float*)a->in[bj ? 32 : 31] + ((size_t)l * NEXP + e) * DM * DFF, DFF, kb * 64, pnl * 128 + c, 32, (bf16_t*)(ws + WS_WGU) + (size_t)e * DM * DM, DM, vn0, kb * 64);
        if (MOE_F8(l)) { d.dp = (bf16_t*)(ws + WS_WGU + (size_t)l * 64 * MiB + (size_t)e * DM * DM + (size_t)vn0 * DM + kb * 64); d.f8s = SW8; }
        d.rs = (const float*)a->in[26] + (size_t)l * DM + kb * 64; return d; }
    r -= 2048; { const int kb = r / 64, ng = r % 64; TrDesc d = tr_desc((const float*)a->in[33] + ((size_t)l * NEXP + e) * DFF * DM, DM, kb * 64, ng * 32, 32, (bf16_t*)(ws + WS_WD) + (size_t)e * DM * DFF, DFF, ng * 32, kb * 64);
        if (MOE_F8(l)) { d.dp = (bf16_t*)(ws + WS_WD + (size_t)l * 32 * MiB + (size_t)e * DM * DFF + (size_t)(ng * 32) * DFF + kb * 64); d.f8s = SW8; }
        return d; }
}
constexpr int H_CLAIM = 144, M_CLAIM = 72, N_CLAIM = 40;
#ifndef CONV_IN_ATTN
#define CONV_IN_ATTN 0
#endif
constexpr int CONV_CH = 392;
__host__ __device__ constexpr int conv_space(int l) { return N_MOE_ITEMS + (l == 0 && DEPTH > 1 ? N_SMALL_ITEMS : 0); }
__host__ __device__ constexpr int conv_chunks(int l) { return (conv_space(l) + CONV_CH - 1) / CONV_CH; }
__device__ __forceinline__ TrDesc conv_desc(const __attribute__((address_space(4))) Args* a, int mode, int l, int it) {
    if (mode == 0) return desc_small(a, l, it);
    if (it < N_MOE_ITEMS) return desc_moe(a, l, it);
    return desc_small(a, 1, it - N_MOE_ITEMS);
}
__device__ __forceinline__ void convert_run(const __attribute__((address_space(4))) Args* a, int mode, int l, int it0, int end, int stride, LAS float* scr, int lane) {
    if (it0 >= end) return;
    const int n = (end - it0 + stride - 1) / stride;
    f32x4 v0[8], v1[8], v2[8], v3[8]; float g_v0[8], g_v1[8], g_v2[8], g_v3[8];
#define CV_LOAD(V, j) do { const TrDesc d_ = conv_desc(a, mode, l, it0 + (j) * stride); tr_load(d_, V, g_##V, lane); } while (0)
#define CV_STORE(V, j) do { const TrDesc d_ = conv_desc(a, mode, l, it0 + (j) * stride); tr_store(d_, V, g_##V, scr, lane); } while (0)
    CV_LOAD(v0, 0);
    if (n > 1) CV_LOAD(v1, 1);
    if (n > 2) CV_LOAD(v2, 2);
    for (int j = 0; j < n; j += 4) {
        if (j + 3 < n) CV_LOAD(v3, j + 3);
        CV_STORE(v0, j);
        if (j + 1 >= n) break;
        if (j + 4 < n) CV_LOAD(v0, j + 4);
        CV_STORE(v1, j + 1);
        if (j + 2 >= n) break;
        if (j + 5 < n) CV_LOAD(v1, j + 5);
        CV_STORE(v2, j + 2);
        if (j + 3 >= n) break;
        if (j + 6 < n) CV_LOAD(v2, j + 6);
        CV_STORE(v3, j + 3);
    }
#undef CV_LOAD
#undef CV_STORE
}

__device__ __forceinline__ void idle_convert(const __attribute__((address_space(4))) Args* a, unsigned* head, int n, volatile LAS unsigned* misc, LAS float* scr, int tid, int wid, int lane) {
    if (tid == 0) misc[2] = __hip_atomic_fetch_add(head, (unsigned)n, __ATOMIC_RELAXED, __HIP_MEMORY_SCOPE_AGENT);
    __syncthreads();
    const int base = __builtin_amdgcn_readfirstlane((int)misc[2]);
    __syncthreads();
    const int total = conv_space(1); if (base >= total) return;
    const int end = base + n < total ? base + n : total;
    convert_run(a, 1, 1, base + wid, end, 8, scr, lane);
}

#define XB_TMO      128
#define XB_XCNT(j)  (256  + 64 * (j))
#define XB_XSUB(j)  (1280 + 64 * (j))
#define XB_XGEN(j)  (2304 + 64 * (j))
#define XB_TOP      3328
#define XB_TOPGEN   3392
#define XCD_BAR_WORDS 3456
#define XB_SPIN_CAP (1u << 22)
__device__ __forceinline__ unsigned xb_ld(unsigned* p)              { return __hip_atomic_load(p, __ATOMIC_RELAXED, __HIP_MEMORY_SCOPE_AGENT); }
__device__ __forceinline__ unsigned xb_add(unsigned* p, unsigned v) { return __hip_atomic_fetch_add(p, v, __ATOMIC_RELAXED, __HIP_MEMORY_SCOPE_AGENT); }
__device__ __forceinline__ unsigned xb_xcc_id() { return (unsigned)__builtin_amdgcn_s_getreg((3 << 11) | 20) & 0xFu; }
#define XB_SPIN(cond, bar) do { unsigned _sp = 0; while (cond) { __builtin_amdgcn_s_sleep(1); \
    if ((++_sp & 255u) == 0u) { if (xb_ld(&(bar)[XB_TMO])) break; if (_sp > XB_SPIN_CAP) { atomicAdd(&(bar)[XB_TMO], 1u); break; } } } } while (0)
struct XcdBarrier { unsigned* bar; unsigned x; volatile LAS unsigned* st; int wid; };
__device__ __forceinline__ XcdBarrier xcd_barrier_post(unsigned* bar, volatile LAS unsigned* st) {
    XcdBarrier b; b.bar = bar; b.x = xb_xcc_id(); b.st = st; b.wid = 0;
    if (threadIdx.x == 0) (void)xb_add(&bar[XB_XCNT(b.x)], 1u);
    return b;
}
__device__ __forceinline__ void xcd_barrier_complete(unsigned* bar, unsigned x, unsigned& nloc, unsigned& nx) {
    const unsigned G = gridDim.x * gridDim.y * gridDim.z;
    unsigned sum, cnt, mine, sp = 0u;
    for (;;) {
        sum = 0u; cnt = 0u; mine = 0u;
#pragma unroll 1
        for (unsigned j = 0; j < 16; ++j) { const unsigned c = xb_ld(&bar[XB_XCNT(j)]); sum += c; cnt += (c > 0u) ? 1u : 0u; mine = (j == x) ? c : mine; }
        if (sum == G) break;
        __builtin_amdgcn_s_sleep(1);
        if ((++sp & 255u) == 0u) { if (xb_ld(&bar[XB_TMO])) break; if (sp > XB_SPIN_CAP) { atomicAdd(&bar[XB_TMO], 1u); break; } }
    }
    nloc = mine > 0u ? mine : 1u; nx = cnt > 0u ? cnt : 1u;
}
__device__ __forceinline__ void xcd_barrier(const XcdBarrier& b) {
    asm volatile("s_waitcnt vmcnt(0)" ::: "memory");
    __syncthreads();
    if (b.wid == 0 && hw_lane() == 0) {
        unsigned* bar = b.bar;
        __builtin_amdgcn_s_waitcnt(0);
        unsigned nloc = b.st[0], nx = b.st[1];
        if (nloc == 0u) { xcd_barrier_complete(bar, b.x, nloc, nx); b.st[0] = nloc; b.st[1] = nx; }
        const unsigned old = xb_add(&bar[XB_XSUB(b.x)], 1u);
        const unsigned gen = old / nloc;
        if (old + 1u == (gen + 1u) * nloc) {
            __builtin_amdgcn_fence(__ATOMIC_RELEASE, "agent");
            asm volatile("s_waitcnt vmcnt(0)" ::: "memory");
            const unsigned og = xb_add(&bar[XB_TOP], 1u);
            const unsigned tg = og / nx;
            if (og + 1u == (tg + 1u) * nx) xb_add(&bar[XB_TOPGEN], 1u);
            else XB_SPIN(xb_ld(&bar[XB_TOPGEN]) == tg, bar);
            __builtin_amdgcn_fence(__ATOMIC_ACQUIRE, "agent");
            xb_add(&bar[XB_XGEN(b.x)], 1u);
            asm volatile("s_waitcnt vmcnt(0)" ::: "memory");
        } else {
            XB_SPIN(xb_ld(&bar[XB_XGEN(b.x)]) == gen, bar);
            __builtin_amdgcn_fence(__ATOMIC_ACQUIRE, "agent");
            asm volatile("s_waitcnt vmcnt(0)" ::: "memory");
        }
    }
    __syncthreads();
}

constexpr int PH_PER_LAYER = 13, N_PHASES = 1 + DEPTH * PH_PER_LAYER + 1;
typedef const __attribute__((address_space(4))) Args* ArgsP;
__device__ __forceinline__ bool in_range(ArgsP p, int k) { asm volatile("" : "+s"(p)); return p->ph_lo <= k && k < p->ph_hi; }
__global__ void __launch_bounds__(512, 2) mega_fwd(Args args_unused) {
    extern __shared__ __attribute__((aligned(16))) unsigned char lds_raw[];
    LAS unsigned char* lds = (LAS unsigned char*)lds_raw;
    volatile LAS unsigned* MISC = (volatile LAS unsigned*)(lds + MISC_OFF);
    volatile LAS int* MOETAB = (volatile LAS int*)(lds + RING_BYTES + 512);
    const ArgsP ap0 = (ArgsP)__builtin_amdgcn_kernarg_segment_ptr();
    const int tid0 = threadIdx.x; const int wid0 = __builtin_amdgcn_readfirstlane(tid0 >> 6);
    const int G = gridDim.x, bx0 = blockIdx.x, NGW = G * 8;
    if (tid0 < 256) ((LAS unsigned*)(lds + RING_BYTES))[tid0] = 0u;
    __syncthreads();
    const int lo = ap0->ph_lo, hi = ap0->ph_hi;
    const bool use_bar = (hi - lo) > 1;
    XcdBarrier bar; bar.bar = (unsigned*)(ap0->ws + WS_CTL) + CW_BAR; bar.x = 0; bar.st = nullptr; bar.wid = wid0;
    if (use_bar) { bar = xcd_barrier_post((unsigned*)(ap0->ws + WS_CTL) + CW_BAR, MISC + 8); bar.wid = wid0; }
#ifndef PHASE_MASK
#define PHASE_MASK 0xFFFF
#endif
#ifndef ITEM_MASK
#define ITEM_MASK 7
#endif
#define ITEM_ON(i) (((ITEM_MASK) >> (i)) & 1)
#define PHON(i) (((PHASE_MASK) >> (i)) & 1)
#ifndef REP_MASK
#define REP_MASK 0
#endif
#ifndef REP_CNT
#define REP_CNT 2
#endif
#define NREP(i) ((((REP_MASK) >> (i)) & 1) ? REP_CNT : 1)
#define IN(k) in_range(ap0, (k))
#define SEAM(k) do { if (IN(k) && IN((k) + 1)) xcd_barrier(bar); } while (0)
#define PHASE_VIEW() ArgsP ap = ap0; asm volatile("" : "+s"(ap)); unsigned char* ws = ap->ws; unsigned* ctl = (unsigned*)(ws + WS_CTL); \
    int bx = bx0; asm volatile("" : "+s"(bx)); int tid = wid0 * 64 + hw_lane(); asm volatile("" : "+v"(tid)); int wid_ = wid0; asm volatile("" : "+s"(wid_)); const int lane = tid & 63, wid = wid_, gw = bx * 8 + wid; LAS float* scr = (LAS float*)(lds + wid * 16384); \
    (void)ctl; (void)lane; (void)gw; (void)scr
#define INP(k) ((const float*)ap->in[k])
    for (int rep = 0; rep < NREP(0); ++rep) if (PHON(0) && IN(0)) { if (rep) xcd_barrier(bar); PHASE_VIEW();
        convert_run(ap, 0, 0, gw, N_SMALL_ITEMS, NGW, scr, lane);
        if (!CONV_IN_ATTN) convert_run(ap, 1, 0, gw, conv_space(0), NGW, scr, lane);
        { const int* pos = (const int*)ap->in[2]; f32x2* r128 = (f32x2*)(ws + WS_ROPE128); f32x2* r64 = (f32x2*)(ws + WS_ROPE64);
          const int i = tid & 63; const float inv = (float)pow(10000.0, -(double)(2 * i) / 128.0);
          for (int idx = bx * 512 + tid; idx < NTOK * 64; idx += G * 512) { const int tk = idx >> 6; const float ang = (float)pos[tk] * inv;
              const f32x2 cs = {cosf(ang), sinf(ang)}; r128[idx] = cs; if ((i & 1) == 0) r64[tk * 32 + (i >> 1)] = cs; } }
        { bf16_t* wr16 = (bf16_t*)(ws + WS_WRT + 512 * 1024);
          for (int idx = bx * 512 + tid; idx < DEPTH * 32 * DM; idx += G * 512) { const int l = idx / (32 * DM), r = idx % (32 * DM), n = r / DM, k = r % DM;
              const float v = (n < 4) ? INP(27)[((size_t)l * DM + k) * 4 + n] : (n < 20 ? INP(29)[((size_t)l * DM + k) * 16 + (n - 4)] : 0.f); wr16[idx] = (bf16_t)f2bf(v * INP(26)[(size_t)l * DM + k]); }
          float* cb = (float*)(ws + WS_CBIAS);
          for (int w = gw; w < DEPTH * 2 * 128 * 4; w += NGW) { const int o = w >> 2, q = w & 3, l = o >> 8, kv = (o >> 7) & 1, n = o & 127; const float* pe = INP(kv ? 7 : 6) + (size_t)l * 4096; const float* w1 = INP(kv ? 10 : 8) + (size_t)l * 4096 * 128;
              float s = 0.f; for (int k = q * 1024 + lane; k < (q + 1) * 1024; k += 64) s += pe[k] * w1[(size_t)k * 128 + n]; s = wave_sum(s); if (lane == 0) cb[w] = s; } }
        for (int r = gw; r < NTOK; r += NGW) rms_row<false, true, 3>(INP(0) + (size_t)r * DM, (bf16_t*)(ws + WS_X) + (size_t)r * DM, INP(3), (bf16_t*)(ws + WS_HA) + (size_t)r * DM, nullptr, nullptr, 0.f, 0.f, lane, (unsigned char*)(ws + WS_OCAT) + (size_t)r * DM);
    }
    SEAM(0);

    for (int l = 0; l < DEPTH; ++l) {
        const int pb = 1 + l * PH_PER_LAYER;
        for (int rep = 0; rep < NREP(1); ++rep) if (PHON(1) && IN(pb + 0) && l > 0) { if (rep) xcd_barrier(bar); PHASE_VIEW();
            if (wid == 0) pg8::moe_table(MOETAB, ctl + CW_CNT + (l - 1) * 16 * 64, lane);
            __syncthreads();
            for (int r = gw; r < NTOK; r += NGW) { const bf16_t *y0, *y1; float w0, w1; moe_row_src(ws, MOETAB, r, y0, y1, w0, w1);
                rms_row<true, true, 3, true>((const bf16_t*)(ws + WS_X) + (size_t)r * DM, (bf16_t*)(ws + WS_X) + (size_t)r * DM, INP(3) + (size_t)l * DM, (bf16_t*)(ws + WS_HA) + (size_t)r * DM, y0, y1, w0, w1, lane, (unsigned char*)(ws + WS_OCAT) + (size_t)r * DM); }
            if (!CONV_IN_ATTN) { __syncthreads(); int c0 = MOE_F8(1) ? (int)ctl[CW_CH] : 0; c0 = c0 < conv_space(l) ? c0 : conv_space(l); convert_run(ap, 1, l, c0 + gw, conv_space(l), NGW, scr, lane); }
        }
        if (l > 0) SEAM(pb + 0);
        for (int rep = 0; rep < NREP(2); ++rep) if (PHON(2) && IN(pb + 1)) { if (rep) xcd_barrier(bar); PHASE_VIEW();
            { pg8::Gemm g{(const bf16_t*)(ws + WS_HA), (const bf16_t*)(ws + WS_WIN) + (size_t)l * NV16 * DM, DM, wid};
              pg8::StaticOrder S; S.init(NTOK, NV16, G, bx, DM);
              EpiInProj E{ws, 1.f, 0, 0, 0};
              pg8::gemm_phase<EpiInProj, pg8::StaticOrder, true, false>(lds, g, S, E); }
            { pg8::Gemm g{(const bf16_t*)(ws + WS_OCAT), (const bf16_t*)(ws + WS_WIN8 + (size_t)l * NV8 * DM), DM, wid};
              pg8::StaticOrder S; S.init(NTOK, NV8, G, bx, DM / 2);
              EpiInProj E{ws, 1.f / (SA8 * SW8), 1, 0, 0};
              pg8::gemm_phase<EpiInProj, pg8::StaticOrder, true, true>(lds, g, S, E); }
        }
        SEAM(pb + 1);
        for (int rep = 0; rep < NREP(4); ++rep) if (PHON(4) && IN(pb + 3)) { if (rep) xcd_barrier(bar); PHASE_VIEW();
            float lam, lambda_init;
            { const float* lq1 = INP(12) + l * 64; const float* lk1 = INP(13) + l * 64; const float* lq2 = INP(14) + l * 64; const float* lk2 = INP(15) + l * 64;
              const float s1 = wave_sum(lq1[lane] * lk1[lane]), s2 = wave_sum(lq2[lane] * lk2[lane]); lambda_init = 0.8f - 0.6f * expf(-0.3f * (float)l); lam = expf(s1) - expf(s2) + lambda_init; }
            for (int r = gw; r < NB * NMEM; r += NGW) rms_row_bf16(INP(1) + (size_t)r * DM, INP(22) + (size_t)l * DM, (bf16_t*)(ws + WS_HM) + (size_t)r * DM, lane);
            unsigned* qh = ctl + CW_Q + l * 64 + rep * 4; unsigned* cdone = ctl + CW_CD + l * 64;
            bool cseen = false;
            for (;;) {
                if (tid == 0) MISC[0] = atomicAdd(qh, 1u);
                __syncthreads();
                const int it = __builtin_amdgcn_readfirstlane((int)MISC[0]);
                __syncthreads();
                const int nch = CONV_IN_ATTN ? conv_chunks(l) : 0;
                if (it >= 128 + 1536 + nch) break;
                int tid_o = tid; asm volatile("" : "+v"(tid_o));
                const int lane = tid_o & 63, wid = __builtin_amdgcn_readfirstlane(tid_o >> 6);
                if (it < 128) {
                    compress_item(lds, ws, l, it >> 6, (it >> 2) & 15, it & 3, wid, lane);
                    asm volatile("s_waitcnt vmcnt(0)" ::: "memory"); __syncthreads();
                    if (tid == 0) __hip_atomic_fetch_add(cdone, 1u, __ATOMIC_RELAXED, __HIP_MEMORY_SCOPE_AGENT);
                    continue;
                }
                const int itq = it - 128;
                const int pq = itq / 9;
                if (itq % 9 == 8 && pq < nch) {
                    const int c0 = pq * CONV_CH, c1 = (c0 + CONV_CH < conv_space(l)) ? c0 + CONV_CH : conv_space(l);
                    convert_run(ap, 1, l, c0 + wid, c1, 8, (LAS float*)(lds + wid * 16384), lane);
                    __syncthreads();
                    continue;
                }
                const int ita = itq - (pq < nch ? pq : nch);
                if (ITEM_ON(0) && ita >= 512 && ita < 1024) { const int i = ita - 512, qb = 31 - (i >> 4), bg = i & 15;
                    if (!cseen) {
                        if (tid == 0) { unsigned sp = 0; while (__hip_atomic_load(cdone, __ATOMIC_RELAXED, __HIP_MEMORY_SCOPE_AGENT) < 128u * (unsigned)(rep + 1)) { __builtin_amdgcn_s_sleep(2); if (++sp > (1u << 22)) break; } }
                        __syncthreads(); __builtin_amdgcn_fence(__ATOMIC_ACQUIRE, "agent"); asm volatile("s_waitcnt vmcnt(0)" ::: "memory"); __syncthreads(); cseen = true; }
                    attn_item_nsa(lds, ws, l, bg >> 1, bg & 1, qb, wid, lane); }
                else if (ITEM_ON(1) && ita < 512) { const int i = ita, qb = 15 - (i >> 5), bh = i & 31; attn_item_diff(lds, ws, INP(16) + l * 128, lam, lambda_init, bh >> 2, bh & 3, qb, wid, lane); }
                else if (ITEM_ON(2) && ita >= 1024) { const int i = ita - 1024, qb = 31 - (i >> 4), bk = i & 15; attn_item_swa(lds, ws, INP(5) + l * 8, bk >> 1, bk & 1, qb, wid, lane); }
            }
        }
        SEAM(pb + 3);
        for (int rep = 0; rep < NREP(5); ++rep) if (PHON(5) && IN(pb + 4)) { if (rep) xcd_barrier(bar); PHASE_VIEW();
            pg8::Gemm g{(const bf16_t*)(ws + WS_OCAT), (const bf16_t*)(ws + WS_WPCAT) + (size_t)l * DM * DM, DM, wid};
            pg8::StaticOrder S; S.init(NTOK, DM, G, bx, DM);
            EpiMerge E{(const unsigned char*)(ws + WS_MG), (bf16_t*)(ws + WS_QKV), 8, 24};
            pg8::gemm_phase<EpiMerge, pg8::StaticOrder, true>(lds, g, S, E);
        }
        SEAM(pb + 4);
        for (int rep = 0; rep < NREP(6); ++rep) if (PHON(6) && IN(pb + 5)) { if (rep) xcd_barrier(bar); PHASE_VIEW();
            pg8::Gemm g{(const bf16_t*)(ws + WS_QKV), (const bf16_t*)(ws + WS_WOUT + (F_F8 ? (size_t)l * DM * DM : (size_t)l * DM * DM * 2)), DM, wid};
            pg8::StaticOrder S; S.init(NTOK, DM, G, bx, F_F8 ? DM / 2 : DM);
            EpiResidual E{(bf16_t*)(ws + WS_X), nullptr, (float*)(ws + WS_SSQ), F_F8 ? 1.f / (SM8 * SW8) : 1.f, 0, 0};
            pg8::gemm_phase<EpiResidual, pg8::StaticOrder, true, F_F8 != 0>(lds, g, S, E);
        }
        SEAM(pb + 5);
        for (int rep = 0; rep < NREP(8); ++rep) if (PHON(8) && IN(pb + 7)) { if (rep) xcd_barrier(bar); PHASE_VIEW();
            pg8::Gemm g{(const bf16_t*)(ws + WS_X), (const bf16_t*)(ws + WS_WXCAT) + (size_t)l * 1536 * DM, DM, wid};
            if (MOE_F8(1) && l == 0 && bx >= 160) idle_convert(ap, ctl + CW_CH, H_CLAIM, MISC, scr, tid, wid, lane);
            pg8::XqOrder S{bx};
            LAS float* rstdl = (LAS float*)(lds + RING_BYTES + 1024);
            if (bx < 128) { const int row = (bx >> 1) * 256 + (tid >> 1); const f32x4* p4 = (const f32x4*)((const float*)(ws + WS_SSQ) + (size_t)row * 32 + (tid & 1) * 16);
                const f32x4 a0 = p4[0], a1 = p4[1], a2 = p4[2], a3 = p4[3]; float sm = ((a0[0] + a0[1]) + (a0[2] + a0[3])) + ((a1[0] + a1[1]) + (a1[2] + a1[3])) + ((a2[0] + a2[1]) + (a2[2] + a2[3])) + ((a3[0] + a3[1]) + (a3[2] + a3[3]));
                sm += __shfl_xor(sm, 1); if ((tid & 1) == 0) rstdl[tid >> 1] = rsqrtf(sm * (1.f / DM) + EPS); }
            __syncthreads();
            EpiXq E{(bf16_t*)(ws + WS_QX), (bf16_t*)(ws + WS_KVM), rstdl, 0, 0};
            pg8::gemm_phase<EpiXq, pg8::XqOrder, false>(lds, g, S, E);
        }
        SEAM(pb + 7);
        for (int rep = 0; rep < NREP(9); ++rep) if (PHON(9) && IN(pb + 8)) { if (rep) xcd_barrier(bar); PHASE_VIEW();
            for (int it = bx; it < 256; it += G) attn_item_cross(lds, ws, it >> 5, (it >> 3) & 3, it & 7, wid, lane);
        }
        SEAM(pb + 8);
        for (int rep = 0; rep < NREP(10); ++rep) if (PHON(10) && IN(pb + 9)) { if (rep) xcd_barrier(bar); PHASE_VIEW();
            pg8::Gemm g{(const bf16_t*)(ws + WS_OX), (const bf16_t*)(ws + WS_WXO) + (size_t)l * DM * 512, 512, wid};
            pg8::StaticOrder S; S.init(NTOK, DM, G, bx, 512);
            EpiResidual E{(bf16_t*)(ws + WS_X), (unsigned char*)(ws + WS_OCAT), (float*)(ws + WS_SSQ) + (size_t)NTOK * 32, 1.f, 0, 0};
            pg8::gemm_phase<EpiResidual, pg8::StaticOrder, true>(lds, g, S, E);
        }
        SEAM(pb + 9);
        for (int rep = 0; rep < NREP(11); ++rep) if (PHON(11) && IN(pb + 10)) { if (rep) xcd_barrier(bar); PHASE_VIEW();
            const float* bgp = INP(28) + l * 4; const float* bep = INP(30) + l * 16;
            const bf16_t* wr16 = (const bf16_t*)(ws + WS_WRT + 512 * 1024) + (size_t)l * 32 * DM;
            int* tokt = (int*)(ws + WS_TOK); unsigned* cntw = ctl + CW_CNT + l * 16 * 64;
            const int r32 = lane & 31, hi = lane >> 5;
            LAS float* P = (LAS float*)lds;
            LAS float* L = (LAS float*)(lds + 32768);
            LAS float* RSL = (LAS float*)(lds + 32768 + 16384);
            for (int rb = bx * 64; rb < NTOK; rb += G * 64) {
                { const int row = tid >> 3; const f32x4 pv_ = *((const f32x4*)((const float*)(ws + WS_SSQ) + (size_t)NTOK * 32 + (size_t)(rb + row) * 32) + (tid & 7));
                  float sm = (pv_[0] + pv_[1]) + (pv_[2] + pv_[3]); sm += __shfl_xor(sm, 1); sm += __shfl_xor(sm, 2); sm += __shfl_xor(sm, 4);
                  if ((tid & 7) == 0) { const float rs_ = rsqrtf(sm * (1.f / DM) + EPS); RSL[row] = rs_; ((float*)(ws + WS_RSTD))[rb + row] = rs_; } }
                __syncthreads();
                { const int tile = wid & 1, kp = wid >> 1; f32x16 acc = (f32x16){};
                  const bf16_t* ap_ = (const bf16_t*)(ws + WS_X) + (size_t)(rb + 32 * tile + r32) * DM + kp * 512 + 8 * hi; const bf16_t* bp_ = wr16 + (size_t)r32 * DM + kp * 512 + 8 * hi;
#pragma unroll 8
                  for (int ks = 0; ks < 32; ++ks) { const bf16x8 a = *(const bf16x8*)(ap_ + 16 * ks), b = *(const bf16x8*)(bp_ + 16 * ks); acc = __builtin_amdgcn_mfma_f32_32x32x16_bf16(a, b, acc, 0, 0, 0); }
                  LAS float* pp = P + wid * 1024 + lane;
#pragma unroll
                  for (int r = 0; r < 16; ++r) pp[r * 64] = acc[r]; }
                __syncthreads();
                if (wid < 2) {
                    LAS float* pp = P + wid * 1024 + lane; LAS float* lp = L + wid * (32 * 33) + r32;
#pragma unroll
                    for (int r = 0; r < 16; ++r) { const float v = (pp[r * 64] + pp[2048 + r * 64]) + (pp[4096 + r * 64] + pp[6144 + r * 64]); lp[((r & 3) + 8 * (r >> 2) + 4 * hi) * 33] = v; }
                    asm volatile("s_waitcnt lgkmcnt(0)" ::: "memory");
                    if (lane < 32) { const int tk = rb + 32 * wid + lane; const LAS float* lr = L + wid * (32 * 33) + lane * 33; const float rsr = RSL[32 * wid + lane];
                        float gl[4]; int gi = 0;
#pragma unroll
                        for (int n = 0; n < 4; ++n) gl[n] = lr[n] * rsr + bgp[n];
                        float gmx = gl[0];
#pragma unroll
                        for (int n = 1; n < 4; ++n) if (gl[n] > gmx) { gmx = gl[n]; gi = n; }
                        float gs = 0.f;
#pragma unroll
                        for (int n = 0; n < 4; ++n) gs += expf(gl[n] - gmx);
                        const float gp = 1.f / gs;
                        float el[4];
#pragma unroll
                        for (int n = 0; n < 4; ++n) el[n] = lr[4 + 4 * gi + n] * rsr + bep[4 * gi + n];
                        int e0 = 0; float m0 = el[0];
#pragma unroll
                        for (int n = 1; n < 4; ++n) if (el[n] > m0) { m0 = el[n]; e0 = n; }
                        int e1 = -1; float m1 = -INFINITY;
#pragma unroll
                        for (int n = 0; n < 4; ++n) if (n != e0 && el[n] > m1) { m1 = el[n]; e1 = n; }
                        const float p1 = expf(m1 - m0); const float w0 = gp / (1.f + p1), w1 = gp * p1 / (1.f + p1);
                        if (rep == 0) { const int ea = gi * 4 + e0, eb = gi * 4 + e1;
                            const unsigned ra = atomicAdd(cntw + ea * 64, 1u), rbk = atomicAdd(cntw + eb * 64, 1u);
                            tokt[ea * NTOK + ra] = tk; tokt[eb * NTOK + rbk] = tk; ((float*)(ws + WS_RSTDT))[ea * NTOK + ra] = rsr; ((float*)(ws + WS_RSTDT))[eb * NTOK + rbk] = rsr;
                            ((int*)(ws + WS_WT))[tk * 4 + 0] = ea; ((int*)(ws + WS_WT))[tk * 4 + 1] = (int)ra; ((int*)(ws + WS_WT))[tk * 4 + 2] = eb; ((int*)(ws + WS_WT))[tk * 4 + 3] = (int)rbk;
                            ((float*)(ws + WS_WT + 512 * 1024))[tk * 2 + 0] = w0; ((float*)(ws + WS_WT + 512 * 1024))[tk * 2 + 1] = w1; } }
                }
                __syncthreads();
            }
        }
        SEAM(pb + 10);
        for (int rep = 0; rep < NREP(12); ++rep) if (PHON(12) && IN(pb + 11)) { if (rep) xcd_barrier(bar); PHASE_VIEW();
            if (wid == 0) pg8::moe_table(MOETAB, ctl + CW_CNT + l * 16 * 64, lane);
            __syncthreads();
            if (MOE_F8(l)) {
                pg8::Gemm g{(const bf16_t*)(ws + WS_OCAT), (const bf16_t*)(ws + WS_WGU + (size_t)l * 64 * MiB), DM, wid};
                pg8::MoeOrder S; S.init(MOETAB, G, bx, (const int*)(ws + WS_TOK), true, DM / 2);
                EpiMoeUp E{(bf16_t*)(ws + WS_HMOE), 1.f / (SA8 * SW8), 1, (const float*)(ws + WS_RSTDT), (const int*)(ws + WS_TOK), MOETAB, 0, 0};
                pg8::gemm_phase<EpiMoeUp, pg8::MoeOrder, true, true>(lds, g, S, E);
                if (MOE_F8(1) && l == 0) { const int per = (S.U + 7) >> 3, i0 = bx >> 3, nb = G >> 3; const int nu = i0 < per ? (per - i0 + nb - 1) / nb : 0, numax = (per + nb - 1) / nb;
                    if (nu < numax) idle_convert(ap, ctl + CW_CH, M_CLAIM, MISC, scr, tid, wid, lane); }
            } else {
                pg8::Gemm g{(const bf16_t*)(ws + WS_X), (const bf16_t*)(ws + WS_WGU), DM, wid};
                pg8::MoeOrder S; S.init(MOETAB, G, bx, (const int*)(ws + WS_TOK), true, DM);
                EpiMoeUp E{(bf16_t*)(ws + WS_HMOE), 1.f, 0, (const float*)(ws + WS_RSTDT), (const int*)(ws + WS_TOK), MOETAB, 0, 0};
                pg8::gemm_phase<EpiMoeUp, pg8::MoeOrder, true>(lds, g, S, E);
            }
        }
        SEAM(pb + 11);
        for (int rep = 0; rep < NREP(13); ++rep) if (PHON(13) && IN(pb + 12)) { if (rep) xcd_barrier(bar); PHASE_VIEW();
            if (wid == 0) pg8::moe_table(MOETAB, ctl + CW_CNT + l * 16 * 64, lane);
            __syncthreads();
            if (MOE_F8(l)) {
                pg8::Gemm g{(const bf16_t*)(ws + WS_HMOE), (const bf16_t*)(ws + WS_WD + (size_t)l * 32 * MiB), DFF, wid};
                pg8::MoeOrder S; S.init(MOETAB, G, bx, (const int*)(ws + WS_TOK), false, DFF / 2);
                EpiMoeDown E{(bf16_t*)(ws + WS_Y), 1.f / (SH8 * SW8), 0, 0};
                pg8::gemm_phase<EpiMoeDown, pg8::MoeOrder, true, true>(lds, g, S, E);
                if (MOE_F8(1) && l == 0) { const int per = (S.U + 7) >> 3, i0 = bx >> 3, nb = G >> 3; const int nu = i0 < per ? (per - i0 + nb - 1) / nb : 0, numax = (per + nb - 1) / nb;
                    if (nu < numax) idle_convert(ap, ctl + CW_CH, N_CLAIM, MISC, scr, tid, wid, lane); }
            } else {
                pg8::Gemm g{(const bf16_t*)(ws + WS_HMOE), (const bf16_t*)(ws + WS_WD), DFF, wid};
                pg8::MoeOrder S; S.init(MOETAB, G, bx, (const int*)(ws + WS_TOK), false, DFF);
                EpiMoeDown E{(bf16_t*)(ws + WS_Y), 1.f, 0, 0};
                pg8::gemm_phase<EpiMoeDown, pg8::MoeOrder, true>(lds, g, S, E);
            }
        }
        SEAM(pb + 12);
    }
    for (int rep = 0; rep < NREP(14); ++rep) if (PHON(14) && IN(N_PHASES - 1)) { if (rep) xcd_barrier(bar); PHASE_VIEW();
        if (wid == 0) pg8::moe_table(MOETAB, ctl + CW_CNT + (DEPTH - 1) * 16 * 64, lane);
        __syncthreads();
        for (int r = gw; r < NTOK; r += NGW) { const bf16_t *y0, *y1; float w0, w1; moe_row_src(ws, MOETAB, r, y0, y1, w0, w1);
            rms_row<true, false, 1, true>((const bf16_t*)(ws + WS_X) + (size_t)r * DM, nullptr, INP(34), ap->out + (size_t)r * DM, y0, y1, w0, w1, lane); }
    }
#undef IN
#undef SEAM
}

#ifndef MK_SPLIT
#define MK_SPLIT 0
#endif
extern "C" void kernel_launch(void* const* d_in, const int* in_sizes, int n_in, void* d_out, int out_size, void* d_ws, size_t ws_size, hipStream_t stream) {
    static int grid = 0;
    if (grid == 0) {
        if (n_in != 35 || out_size != NTOK * DM || ws_size < WS_END) { fprintf(stderr, "kernel_launch: unexpected problem (n_in %d, out %d, ws %zu < %zu)\n", n_in, out_size, ws_size, (size_t)WS_END); grid = -1; return; }
        int dev = 0, cus = 0, per_cu = 0;
        if (hipGetDevice(&dev) != hipSuccess || hipDeviceGetAttribute(&cus, hipDeviceAttributeMultiprocessorCount, dev) != hipSuccess) { grid = -1; return; }
        if (hipFuncSetAttribute((const void*)mega_fwd, hipFuncAttributeMaxDynamicSharedMemorySize, LDS_BYTES) != hipSuccess) { fprintf(stderr, "kernel_launch: hipFuncSetAttribute failed\n"); grid = -1; return; }
        if (hipOccupancyMaxActiveBlocksPerMultiprocessor(&per_cu, (const void*)mega_fwd, 512, LDS_BYTES) != hipSuccess || per_cu < 1) { fprintf(stderr, "kernel_launch: occupancy query says %d\n", per_cu); }
        (void)hipGetLastError();
        grid = cus;
        if (grid % 8 != 0) grid -= grid % 8;
    }
    if (grid < 0) return;
    (void)hipMemsetAsync((char*)d_ws + WS_CTL, 0, CTL_BYTES, stream);
    Args a{};
    for (int i = 0; i < 35; ++i) a.in[i] = d_in[i];
    a.out = (float*)d_out; a.ws = (unsigned char*)d_ws;
#if MK_SPLIT
    for (int p = 0; p < N_PHASES; ++p) {
        if (p == 1) continue;
        a.ph_lo = p; a.ph_hi = p + 1;
        hipLaunchKernelGGL(mega_fwd, dim3(grid), dim3(512), LDS_BYTES, stream, a);
    }
#else
    a.ph_lo = 0; a.ph_hi = N_PHASES;
    hipLaunchKernelGGL(mega_fwd, dim3(grid), dim3(512), LDS_BYTES, stream, a);
#endif
}
```
